# Optimizing an MI355X kernel written in HIP

```python
import jax, jax.numpy as jnp
from jax import lax
import numpy as np

D_MODEL = 1024
BATCH = 8
SEQ = 4096
DEPTH = 1

HEAD_DIM = 128
HEADS_PER_GROUP = 4
DILATED_GROUPS = ((128, 1), (512, 4), (2048, 16))
N_GROUPS = 3
N_ATTN_HEADS = N_GROUPS * HEADS_PER_GROUP
ATTN_WIDTH = N_ATTN_HEADS * HEAD_DIM
ATTN_OUT_WIDTH = HEADS_PER_GROUP * HEAD_DIM
BLOCK = 128
CONV_WIDTH = D_MODEL
CONV_K = 3
D_FF = 4 * D_MODEL
N_MOD = 6
IN_COLS = 3 * ATTN_WIDTH + 3 * CONV_WIDTH + 2 * D_MODEL
EPS = 1e-6
NEG_INF = -1e30

kernel_name = "hybrid_dilated_attn_shortconv_gated_block"


def rmsnorm(x, g):
    xf = x.astype(jnp.float32)
    y = xf * lax.rsqrt(jnp.mean(xf * xf, axis=-1, keepdims=True) + EPS)
    return (y * g.astype(jnp.float32)).astype(x.dtype)


def alibi_slopes(n):
    return 2.0 ** (-8.0 * jnp.arange(1, n + 1, dtype=jnp.float32) / n)


def dilated_window_attention(q, k, v, window, dilation, slopes):
    B, S, H, E = q.shape
    n_win = window // dilation
    span = dilation * BLOCK
    s_pad = -(-S // span) * span
    L = s_pad // dilation
    nb = L // BLOCK

    def to_blocks(t):
        t = jnp.pad(t, ((0, 0), (0, s_pad - S), (0, 0), (0, 0)))
        t = t.reshape(B, L, dilation, H, E).transpose(0, 2, 1, 3, 4)
        return t.reshape(B, dilation, nb, BLOCK, H, E)

    def with_prev(t):
        prev = jnp.concatenate([jnp.zeros_like(t[:, :, :1]), t[:, :, :-1]], axis=2)
        return jnp.concatenate([prev, t], axis=3)

    qb = to_blocks(q)
    kw = with_prev(to_blocks(k))
    vw = with_prev(to_blocks(v))

    scores = jnp.einsum('brnqhe,brnkhe->brnhqk', qb, kw,
                        preferred_element_type=jnp.float32) * (E ** -0.5)
    qi = jnp.arange(BLOCK)[:, None]
    kj = jnp.arange(2 * BLOCK)[None, :]
    delta = BLOCK + qi - kj
    in_window = (delta >= 0) & (delta <= n_win)
    has_key = (jnp.arange(nb)[:, None, None] > 0) | (kj[None] >= BLOCK)
    mask = in_window[None] & has_key
    bias = -slopes[:, None, None] * (delta * dilation).astype(jnp.float32)
    scores = jnp.where(mask[:, None], scores + bias, NEG_INF)

    m = jnp.max(scores, axis=-1, keepdims=True)
    p = jnp.exp(scores - m)
    denom = jnp.sum(p, axis=-1, keepdims=True)
    o = jnp.einsum('brnhqk,brnkhe->brnqhe', p, vw.astype(jnp.float32))
    o = o / jnp.swapaxes(denom, 3, 4)
    lse = (m + jnp.log(denom))[..., 0]

    o = o.reshape(B, dilation, L, H, E).transpose(0, 2, 1, 3, 4).reshape(B, s_pad, H, E)[:, :S]
    lse = lse.transpose(0, 1, 2, 4, 3).reshape(B, dilation, L, H)
    lse = lse.transpose(0, 2, 1, 3).reshape(B, s_pad, H)[:, :S]
    return o, lse


def causal_short_conv(u, w):
    return lax.conv_general_dilated(
        u, w[:, None, :].astype(u.dtype), window_strides=(1,), padding=[(CONV_K - 1, 0)],
        dimension_numbers=('NWC', 'WIO', 'NWC'), feature_group_count=u.shape[-1])


def setup_inputs(seed: int = 0) -> dict:
    key = jax.random.key(seed)
    ks = jax.random.split(key, 16)
    f32 = jnp.float32
    nrm = lambda k, shape, s: jax.random.normal(k, shape, f32) * s
    return {
        "x": jax.random.normal(ks[0], (BATCH, SEQ, D_MODEL), f32),
        "c": jax.random.normal(ks[1], (BATCH, D_MODEL), f32),
        "w_ada": nrm(ks[2], (DEPTH, D_MODEL, N_MOD * D_MODEL), D_MODEL ** -0.5),
        "b_ada": nrm(ks[3], (DEPTH, N_MOD * D_MODEL), 0.01),
        "g_norm_mix": 1.0 + nrm(ks[4], (DEPTH, D_MODEL), 0.02),
        "w_in": nrm(ks[5], (DEPTH, D_MODEL, IN_COLS), D_MODEL ** -0.5),
        "b_gate": nrm(ks[6], (DEPTH, 2 * D_MODEL), 0.01),
        "conv_w": nrm(ks[7], (DEPTH, CONV_K, CONV_WIDTH), CONV_K ** -0.5),
        "w_branch_attn": nrm(ks[8], (DEPTH, ATTN_OUT_WIDTH, D_MODEL), ATTN_OUT_WIDTH ** -0.5),
        "w_branch_conv": nrm(ks[9], (DEPTH, CONV_WIDTH, D_MODEL), CONV_WIDTH ** -0.5),
        "w_out": nrm(ks[10], (DEPTH, D_MODEL, D_MODEL), D_MODEL ** -0.5),
        "g_norm_mlp": 1.0 + nrm(ks[11], (DEPTH, D_MODEL), 0.02),
        "w_mlp_in": nrm(ks[12], (DEPTH, D_MODEL, D_FF), D_MODEL ** -0.5),
        "w_mlp_out": nrm(ks[13], (DEPTH, D_FF, D_MODEL), D_FF ** -0.5),
        "g_norm_final": 1.0 + nrm(ks[14], (D_MODEL,), 0.02),
    }


def reference(x, c, w_ada, b_ada, g_norm_mix, w_in, b_gate, conv_w, w_branch_attn,
              w_branch_conv, w_out, g_norm_mlp, w_mlp_in, w_mlp_out, g_norm_final):
    B, S, D = x.shape
    slopes = alibi_slopes(N_ATTN_HEADS)
    widths = [ATTN_WIDTH] * 3 + [CONV_WIDTH] * 3 + [D_MODEL]
    split_pts = [int(s) for s in np.cumsum(widths)]
    c_act = jax.nn.silu(c)
    for l in range(DEPTH):
        mod = (c_act @ w_ada[l] + b_ada[l])[:, None, :]
        shift1, scale1, gate1, shift2, scale2, gate2 = jnp.split(mod, N_MOD, axis=-1)

        h = rmsnorm(x, g_norm_mix[l]) * (1.0 + scale1) + shift1
        proj = h @ w_in[l]
        q, k, v, cb, cc, cx, g_a, g_b = jnp.split(proj, split_pts, axis=-1)
        q = q.reshape(B, S, N_ATTN_HEADS, HEAD_DIM)
        k = k.reshape(B, S, N_ATTN_HEADS, HEAD_DIM)
        v = v.reshape(B, S, N_ATTN_HEADS, HEAD_DIM)

        outs, lses = [], []
        for gi, (window, dilation) in enumerate(DILATED_GROUPS):
            hs = slice(gi * HEADS_PER_GROUP, (gi + 1) * HEADS_PER_GROUP)
            o_g, lse_g = dilated_window_attention(q[:, :, hs], k[:, :, hs], v[:, :, hs],
                                                  window, dilation, slopes[hs])
            outs.append(o_g)
            lses.append(lse_g)
        w_grp = jax.nn.softmax(jnp.stack(lses), axis=0)
        o_attn = jnp.einsum('gbsh,gbshe->bshe', w_grp, jnp.stack(outs))
        y_attn = o_attn.reshape(B, S, ATTN_OUT_WIDTH).astype(x.dtype) @ w_branch_attn[l]

        u = causal_short_conv(cc * cx, conv_w[l])
        y_conv = (cb * u) @ w_branch_conv[l]

        ba, bb = jnp.split(b_gate[l], 2)
        merged = jax.nn.sigmoid(g_a + ba) * y_attn + jax.nn.sigmoid(g_b + bb) * y_conv
        x = x + gate1 * (merged @ w_out[l])

        h2 = rmsnorm(x, g_norm_mlp[l]) * (1.0 + scale2) + shift2
        x = x + gate2 * (jnp.square(jax.nn.relu(h2 @ w_mlp_in[l])) @ w_mlp_out[l])
    return rmsnorm(x, g_norm_final)
```

```cpp
#include <hip/hip_runtime.h>
#include <cstdio>
#include <cstdint>

typedef unsigned short bf16_t;
typedef short bf16x8 __attribute__((ext_vector_type(8)));
typedef float f32x4 __attribute__((ext_vector_type(4)));
typedef unsigned u32x4 __attribute__((ext_vector_type(4)));
typedef unsigned u32x2 __attribute__((ext_vector_type(2)));

constexpr int NB = 8, SEQ = 4096, DM = 1024, M = NB * SEQ, NH = 12, HD = 128, AW = NH * HD  , FF = 4096;
constexpr int NIN = 3 * AW + 3 * DM + 2 * DM;
constexpr int NQKV = 3 * AW;
constexpr int NREST = NIN - NQKV;
constexpr float EPS = 1e-6f;
constexpr float LOG2E = 1.4426950408889634f;
constexpr float QSCALE = 0.08838834764831845f * LOG2E;

constexpr size_t MiB = 1u << 20;
constexpr size_t WS_CTL = 0;
constexpr size_t WS_MODF = 3 * MiB;
constexpr size_t WS_GS1 = WS_MODF + 256 * 1024, WS_GS2 = WS_MODF + 320 * 1024, WS_BIAS2 = WS_MODF + 384 * 1024;
constexpr size_t WS_R1 = 4 * MiB;
constexpr size_t WS_LSE = 8 * MiB;
constexpr size_t WS_WIN = 10 * MiB;
constexpr size_t WS_WBA = 29 * MiB;
constexpr size_t WS_WBC = 30 * MiB;
constexpr size_t WS_WOUT = 32 * MiB;
constexpr size_t WS_WMI = 34 * MiB;
constexpr size_t WS_WMO = 42 * MiB;
constexpr size_t WS_Q = 64 * MiB, WS_K = 160 * MiB, WS_V = 256 * MiB;
constexpr size_t WS_H = 352 * MiB;
constexpr size_t WS_OA = 416 * MiB;
constexpr size_t WS_CB = 160 * MiB, WS_CC = 224 * MiB, WS_CX = 288 * MiB, WS_SA = 448 * MiB, WS_SB = 64 * MiB;
constexpr size_t WS_MC = 224 * MiB;
constexpr size_t WS_M1 = 352 * MiB;
constexpr size_t WS_A1 = 448 * MiB;
constexpr size_t WS_T = 64 * MiB;
constexpr size_t WS_END = 512 * MiB;

__device__ __forceinline__ unsigned f2bf(float f) { unsigned u = __builtin_bit_cast(unsigned, f); return (u + 0x7fffu + ((u >> 16) & 1u)) >> 16; }
__device__ __forceinline__ unsigned pk2(float lo, float hi) { return f2bf(lo) | (f2bf(hi) << 16); }
__device__ __forceinline__ float bf2f(unsigned short b) { return __builtin_bit_cast(float, (unsigned)b << 16); }
__device__ __forceinline__ float wave_sum(float v) {
#pragma unroll
    for (int o = 1; o < 64; o <<= 1) v += __shfl_xor(v, o);
    return v;
}
__device__ __forceinline__ float wave_max(float v) {
#pragma unroll
    for (int o = 1; o < 64; o <<= 1) v = fmaxf(v, __shfl_xor(v, o));
    return v;
}

__global__ void k_transpose(const float* __restrict__ W, int K, int N, int n_lo, int n_cnt, bf16_t* __restrict__ WT, int row_off) {
    const long idx = (long)blockIdx.x * blockDim.x + threadIdx.x;
    const long total = (long)n_cnt * (K / 8);
    if (idx >= total) return;
    const int n = (int)(idx % n_cnt), kc = (int)(idx / n_cnt);
    float v[8];
#pragma unroll
    for (int j = 0; j < 8; ++j) v[j] = W[(size_t)(kc * 8 + j) * N + n_lo + n];
    u32x4 o = {pk2(v[0], v[1]), pk2(v[2], v[3]), pk2(v[4], v[5]), pk2(v[6], v[7])};
    *(u32x4*)(WT + (size_t)(row_off + n) * K + kc * 8) = o;
}

__global__ void k_mod(const float* __restrict__ c, const float* __restrict__ w_ada, const float* __restrict__ b_ada, float* __restrict__ modf) {
    const int n = blockIdx.x * blockDim.x + threadIdx.x;
    float acc[NB];
#pragma unroll
    for (int b = 0; b < NB; ++b) acc[b] = b_ada[n];
    for (int k = 0; k < DM; ++k) {
        const float w = w_ada[(size_t)k * 6 * DM + n];
#pragma unroll
        for (int b = 0; b < NB; ++b) { const float cv = c[b * DM + k]; acc[b] += (cv / (1.f + __expf(-cv))) * w; }
    }
#pragma unroll
    for (int b = 0; b < NB; ++b) modf[b * 6 * DM + n] = acc[b];
}
__global__ void k_derived(const float* __restrict__ modf, const float* __restrict__ g_mix, const float* __restrict__ g_mlp, const float* __restrict__ w_mlp_in,
                          float* __restrict__ gs1, float* __restrict__ gs2, float* __restrict__ bias2) {
    const int n = blockIdx.x * blockDim.x + threadIdx.x;
    if (n < DM) {
#pragma unroll
        for (int b = 0; b < NB; ++b) { gs1[b * DM + n] = g_mix[n] * (1.f + modf[b * 6 * DM + 1 * DM + n]); gs2[b * DM + n] = g_mlp[n] * (1.f + modf[b * 6 * DM + 4 * DM + n]); }
    }
    float acc[NB];
#pragma unroll
    for (int b = 0; b < NB; ++b) acc[b] = 0.f;
    for (int k = 0; k < DM; ++k) {
        const float w = w_mlp_in[(size_t)k * FF + n];
#pragma unroll
        for (int b = 0; b < NB; ++b) acc[b] += modf[b * 6 * DM + 3 * DM + k] * w;
    }
#pragma unroll
    for (int b = 0; b < NB; ++b) bias2[b * FF + n] = acc[b];
}

__global__ void k_h(const float* __restrict__ x, const float* __restrict__ gs1, const float* __restrict__ modf, bf16_t* __restrict__ H) {
    const int lane = threadIdx.x & 63; const int m = blockIdx.x * 4 + (threadIdx.x >> 6); const int b = m / SEQ;
    const f32x4* xr = (const f32x4*)(x + (size_t)m * DM) + lane;
    f32x4 v[4]; float s = 0.f;
#pragma unroll
    for (int j = 0; j < 4; ++j) { v[j] = xr[64 * j]; s += (v[j].x * v[j].x + v[j].y * v[j].y) + (v[j].z * v[j].z + v[j].w * v[j].w); }
    const float r = 1.0f / sqrtf(wave_sum(s) * (1.f / DM) + EPS);
    u32x2* o = (u32x2*)(H + (size_t)m * DM) + lane;
#pragma unroll
    for (int j = 0; j < 4; ++j) {
        const f32x4 g = ((const f32x4*)(gs1 + b * DM))[lane + 64 * j], sh = ((const f32x4*)(modf + b * 6 * DM))[lane + 64 * j];
        const f32x4 h = v[j] * r * g + sh;
        o[64 * j] = (u32x2){pk2(h.x, h.y), pk2(h.z, h.w)};
    }
}

template <class Epi>
__global__ void __launch_bounds__(256) k_gemm_simple(const bf16_t* __restrict__ A, const bf16_t* __restrict__ Bt, int Mm, int N, int K, Epi e) {
    const int wave = threadIdx.x >> 6, lane = threadIdx.x & 63, r = lane & 15, g = lane >> 4;
    const int tiles_n = N / 64;
    const long tile = (long)blockIdx.x * 4 + wave;
    const int tm = (int)(tile / tiles_n), tn = (int)(tile % tiles_n);
    if (tm * 64 >= Mm) return;
    f32x4 acc[4][4];
#pragma unroll
    for (int i = 0; i < 4; ++i)
#pragma unroll
        for (int j = 0; j < 4; ++j) acc[i][j] = (f32x4){0.f, 0.f, 0.f, 0.f};
    const bf16_t* Ap = A + (size_t)(tm * 64 + r) * K + 8 * g;
    const bf16_t* Bp = Bt + (size_t)(tn * 64 + r) * K + 8 * g;
    for (int k0 = 0; k0 < K; k0 += 32) {
        bf16x8 a[4], b[4];
#pragma unroll
        for (int i = 0; i < 4; ++i) { a[i] = *(const bf16x8*)(Ap + (size_t)i * 16 * K + k0); b[i] = *(const bf16x8*)(Bp + (size_t)i * 16 * K + k0); }
#pragma unroll
        for (int i = 0; i < 4; ++i)
#pragma unroll
            for (int j = 0; j < 4; ++j) acc[i][j] = __builtin_amdgcn_mfma_f32_16x16x32_bf16(a[i], b[j], acc[i][j], 0, 0, 0);
    }
#pragma unroll
    for (int i = 0; i < 4; ++i)
#pragma unroll
        for (int j = 0; j < 4; ++j)
#pragma unroll
            for (int q = 0; q < 4; ++q) e(tm * 64 + i * 16 + 4 * g + q, tn * 64 + j * 16 + r, acc[i][j][q]);
}

struct EQkv { bf16_t *Q, *K, *V;
    __device__ __forceinline__ void operator()(int row, int col, float a) const {
        const int t = col / AW, c = col - t * AW; bf16_t* dst = t == 0 ? Q : (t == 1 ? K : V);
        dst[(size_t)row * AW + c] = (bf16_t)f2bf(t == 0 ? a * QSCALE : a); } };
struct ERest { bf16_t *CB, *CC, *CX, *SA, *SB; const float* b_gate;
    __device__ __forceinline__ void operator()(int row, int col, float a) const {
        const int t = col / DM, c = col - t * DM; const size_t i = (size_t)row * DM + c;
        if (t == 0) CB[i] = (bf16_t)f2bf(a);
        else if (t == 1) CC[i] = (bf16_t)f2bf(a);
        else if (t == 2) CX[i] = (bf16_t)f2bf(a);
        else { const float z = a + b_gate[(t - 3) * DM + c]; const float sg = 1.f / (1.f + __expf(-z));
            if (t == 3) SA[i] = (bf16_t)f2bf(sg); else SB[i] = (bf16_t)f2bf(sg); } } };
struct EMc { const bf16_t* SB; bf16_t* MC;
    __device__ __forceinline__ void operator()(int row, int col, float a) const { const size_t i = (size_t)row * DM + col; MC[i] = (bf16_t)f2bf(bf2f(SB[i]) * a); } };
struct EM1 { const bf16_t* SA; const bf16_t* MC; bf16_t* M1;
    __device__ __forceinline__ void operator()(int row, int col, float a) const { const size_t i = (size_t)row * DM + col; M1[i] = (bf16_t)f2bf(bf2f(SA[i]) * a + bf2f(MC[i])); } };
struct EX1 { const float* x; const float* modf; const float* gs2; float* x1; bf16_t* A1;
    __device__ __forceinline__ void operator()(int row, int col, float a) const { const size_t i = (size_t)row * DM + col; const int b = row / SEQ;
        const float v = x[i] + modf[b * 6 * DM + 2 * DM + col] * a; x1[i] = v; A1[i] = (bf16_t)f2bf(v * gs2[b * DM + col]); } };
struct ET { const float* r1; const float* bias2; bf16_t* T;
    __device__ __forceinline__ void operator()(int row, int col, float a) const { const int b = row / SEQ;
        float v = r1[row] * a + bias2[b * FF + col]; v = fmaxf(v, 0.f); T[(size_t)row * FF + col] = (bf16_t)f2bf(v * v); } };
struct EX2 { const float* modf; float* x1;
    __device__ __forceinline__ void operator()(int row, int col, float a) const { const size_t i = (size_t)row * DM + col; const int b = row / SEQ;
        x1[i] = x1[i] + modf[b * 6 * DM + 5 * DM + col] * a; } };

__global__ void __launch_bounds__(256) k_attn_simple(bf16_t* QO, const bf16_t* __restrict__ Kb, const bf16_t* __restrict__ Vb, float* __restrict__ LSE) {
    __shared__ __attribute__((aligned(16))) bf16_t qs[4][HD];
    __shared__ float ps[4][192];
    const int wave = threadIdx.x >> 6, lane = threadIdx.x & 63;
    const long wid = (long)blockIdx.x * 4 + wave;
    const int m = (int)(wid / NH), h = (int)(wid % NH);
    const int b = m / SEQ, t = m % SEQ;
    const int grp = h >> 2, d = grp == 0 ? 1 : (grp == 1 ? 4 : 16);
    const int r = t % d, j = t / d;
    const float slope2 = exp2f(-8.0f * (float)(h + 1) / 12.0f) * (float)d * LOG2E;
    ((unsigned*)qs[wave])[lane] = ((const unsigned*)(QO + (size_t)m * AW + h * HD))[lane];
    __syncthreads();
    float sc[3];
#pragma unroll
    for (int rr = 0; rr < 3; ++rr) {
        const int dl = rr * 64 + lane; const bool valid = dl <= 128 && j - dl >= 0;
        float s = -INFINITY;
        if (valid) {
            const bf16_t* kr = Kb + ((size_t)b * SEQ + (size_t)(j - dl) * d + r) * AW + h * HD;
            float acc = 0.f;
#pragma unroll
            for (int ch = 0; ch < 16; ++ch) {
                const u32x4 kv = *(const u32x4*)(kr + ch * 8); const u32x4 qv = *(const u32x4*)(qs[wave] + ch * 8);
#pragma unroll
                for (int e = 0; e < 4; ++e) {
                    acc += __builtin_bit_cast(float, kv[e] << 16) * __builtin_bit_cast(float, qv[e] << 16);
                    acc += __builtin_bit_cast(float, kv[e] & 0xffff0000u) * __builtin_bit_cast(float, qv[e] & 0xffff0000u);
                }
            }
            s = acc - slope2 * (float)dl;
        }
        sc[rr] = s;
    }
    const float mx = wave_max(fmaxf(fmaxf(sc[0], sc[1]), sc[2]));
    float lsum = 0.f;
#pragma unroll
    for (int rr = 0; rr < 3; ++rr) { const float p = exp2f(sc[rr] - mx); lsum += p; ps[wave][rr * 64 + lane] = p; }
    lsum = wave_sum(lsum);
    __syncthreads();
    float o0 = 0.f, o1 = 0.f;
    const int nk = j < 128 ? j : 128;
    for (int dl = 0; dl <= nk; ++dl) {
        const float p = ps[wave][dl];
        const unsigned vv = ((const unsigned*)(Vb + ((size_t)b * SEQ + (size_t)(j - dl) * d + r) * AW + h * HD))[lane];
        o0 += p * __builtin_bit_cast(float, vv << 16); o1 += p * __builtin_bit_cast(float, vv & 0xffff0000u);
    }
    const float inv = 1.f / lsum;
    ((unsigned*)(QO + (size_t)m * AW + h * HD))[lane] = pk2(o0 * inv, o1 * inv);
    if (lane == 0) LSE[(size_t)m * NH + h] = mx + log2f(lsum);
}

__global__ void k_merge(const bf16_t* __restrict__ O, const float* __restrict__ LSE, bf16_t* __restrict__ OA) {
    const long idx = (long)blockIdx.x * blockDim.x + threadIdx.x;
    const int ch = (int)(idx & 15), slot = (int)((idx >> 4) & 3); const int m = (int)(idx >> 6);
    const float l0 = LSE[(size_t)m * NH + slot], l1 = LSE[(size_t)m * NH + 4 + slot], l2 = LSE[(size_t)m * NH + 8 + slot];
    const float mx = fmaxf(fmaxf(l0, l1), l2); float w0 = exp2f(l0 - mx), w1 = exp2f(l1 - mx), w2 = exp2f(l2 - mx);
    const float inv = 1.f / (w0 + w1 + w2); w0 *= inv; w1 *= inv; w2 *= inv;
    const u32x4 a = *(const u32x4*)(O + (size_t)m * AW + (0 + slot) * HD + ch * 8), bq = *(const u32x4*)(O + (size_t)m * AW + (4 + slot) * HD + ch * 8), cq = *(const u32x4*)(O + (size_t)m * AW + (8 + slot) * HD + ch * 8);
    u32x4 o;
#pragma unroll
    for (int e = 0; e < 4; ++e) {
        const float lo = w0 * __builtin_bit_cast(float, a[e] << 16) + w1 * __builtin_bit_cast(float, bq[e] << 16) + w2 * __builtin_bit_cast(float, cq[e] << 16);
        const float hi = w0 * __builtin_bit_cast(float, a[e] & 0xffff0000u) + w1 * __builtin_bit_cast(float, bq[e] & 0xffff0000u) + w2 * __builtin_bit_cast(float, cq[e] & 0xffff0000u);
        o[e] = pk2(lo, hi);
    }
    *(u32x4*)(OA + (size_t)m * 512 + slot * HD + ch * 8) = o;
}

__global__ void k_conv(bf16_t* CB, const bf16_t* __restrict__ CC, const bf16_t* __restrict__ CX, const float* __restrict__ cw) {
    const long idx = (long)blockIdx.x * blockDim.x + threadIdx.x;
    const int ch = (int)(idx & 127); const int m = (int)(idx >> 7); const int t = m % SEQ;
    float u[8];
#pragma unroll
    for (int e = 0; e < 8; ++e) u[e] = 0.f;
#pragma unroll
    for (int tap = 0; tap < 3; ++tap) {
        const int back = 2 - tap;
        if (t - back >= 0) {
            const u32x4 a = *(const u32x4*)(CC + (size_t)(m - back) * DM + ch * 8), bq = *(const u32x4*)(CX + (size_t)(m - back) * DM + ch * 8);
#pragma unroll
            for (int e = 0; e < 4; ++e) {
                u[2 * e] += cw[tap * DM + ch * 8 + 2 * e] * (__builtin_bit_cast(float, a[e] << 16) * __builtin_bit_cast(float, bq[e] << 16));
                u[2 * e + 1] += cw[tap * DM + ch * 8 + 2 * e + 1] * (__builtin_bit_cast(float, a[e] & 0xffff0000u) * __builtin_bit_cast(float, bq[e] & 0xffff0000u));
            }
        }
    }
    const u32x4 cbv = *(const u32x4*)(CB + (size_t)m * DM + ch * 8); u32x4 o;
#pragma unroll
    for (int e = 0; e < 4; ++e) o[e] = pk2(__builtin_bit_cast(float, cbv[e] << 16) * u[2 * e], __builtin_bit_cast(float, cbv[e] & 0xffff0000u) * u[2 * e + 1]);
    *(u32x4*)(CB + (size_t)m * DM + ch * 8) = o;
}

__global__ void k_rstd(const float* __restrict__ x1, float* __restrict__ r1) {
    const int lane = threadIdx.x & 63; const int m = blockIdx.x * 4 + (threadIdx.x >> 6);
    const f32x4* xr = (const f32x4*)(x1 + (size_t)m * DM) + lane; float s = 0.f;
#pragma unroll
    for (int j = 0; j < 4; ++j) { const f32x4 v = xr[64 * j]; s += (v.x * v.x + v.y * v.y) + (v.z * v.z + v.w * v.w); }
    s = wave_sum(s);
    if (lane == 0) r1[m] = 1.0f / sqrtf(s * (1.f / DM) + EPS);
}
__global__ void k_final(float* xo, const float* __restrict__ gf) {
    const int lane = threadIdx.x & 63; const int m = blockIdx.x * 4 + (threadIdx.x >> 6);
    f32x4* xr = (f32x4*)(xo + (size_t)m * DM) + lane; f32x4 v[4]; float s = 0.f;
#pragma unroll
    for (int j = 0; j < 4; ++j) { v[j] = xr[64 * j]; s += (v[j].x * v[j].x + v[j].y * v[j].y) + (v[j].z * v[j].z + v[j].w * v[j].w); }
    const float r = 1.0f / sqrtf(wave_sum(s) * (1.f / DM) + EPS);
#pragma unroll
    for (int j = 0; j < 4; ++j) xr[64 * j] = v[j] * r * ((const f32x4*)gf)[lane + 64 * j];
}

template <class Epi> static void gemm_simple(const bf16_t* A, const bf16_t* Bt, int Mm, int N, int K, Epi e, hipStream_t s) {
    const long tiles = (long)(Mm / 64) * (N / 64);
    hipLaunchKernelGGL(k_gemm_simple<Epi>, dim3((unsigned)(tiles / 4)), dim3(256), 0, s, A, Bt, Mm, N, K, e);
}
static void transpose(const float* W, int K, int N, int n_lo, int n_cnt, bf16_t* WT, int row_off, hipStream_t s) {
    const long total = (long)n_cnt * (K / 8);
    hipLaunchKernelGGL(k_transpose, dim3((unsigned)((total + 255) / 256)), dim3(256), 0, s, W, K, N, n_lo, n_cnt, WT, row_off);
}

extern "C" void kernel_launch(void* const* d_in, const int* in_sizes, int n_in, void* d_out, int out_size, void* d_ws, size_t ws_size, hipStream_t stream) {
    if (n_in != 15 || out_size != M * DM || ws_size < WS_END) { fprintf(stderr, "kernel_launch: unexpected shapes (n_in %d out %d ws %zu)\n", n_in, out_size, ws_size); return; }
    const float* x = (const float*)d_in[0]; const float* c = (const float*)d_in[1]; const float* w_ada = (const float*)d_in[2]; const float* b_ada = (const float*)d_in[3];
    const float* g_mix = (const float*)d_in[4]; const float* w_in = (const float*)d_in[5]; const float* b_gate = (const float*)d_in[6]; const float* conv_w = (const float*)d_in[7];
    const float* w_ba = (const float*)d_in[8]; const float* w_bc = (const float*)d_in[9]; const float* w_out = (const float*)d_in[10]; const float* g_mlp = (const float*)d_in[11];
    const float* w_mi = (const float*)d_in[12]; const float* w_mo = (const float*)d_in[13]; const float* g_fin = (const float*)d_in[14];
    unsigned char* ws = (unsigned char*)d_ws; float* out = (float*)d_out;
    float* modf = (float*)(ws + WS_MODF); float* gs1 = (float*)(ws + WS_GS1); float* gs2 = (float*)(ws + WS_GS2); float* bias2 = (float*)(ws + WS_BIAS2);
    float* r1 = (float*)(ws + WS_R1); float* lse = (float*)(ws + WS_LSE);
    bf16_t* WIN = (bf16_t*)(ws + WS_WIN); bf16_t* WBA = (bf16_t*)(ws + WS_WBA); bf16_t* WBC = (bf16_t*)(ws + WS_WBC); bf16_t* WOUT = (bf16_t*)(ws + WS_WOUT);
    bf16_t* WMI = (bf16_t*)(ws + WS_WMI); bf16_t* WMO = (bf16_t*)(ws + WS_WMO);
    bf16_t* Q = (bf16_t*)(ws + WS_Q); bf16_t* Kb = (bf16_t*)(ws + WS_K); bf16_t* Vb = (bf16_t*)(ws + WS_V); bf16_t* H = (bf16_t*)(ws + WS_H); bf16_t* OA = (bf16_t*)(ws + WS_OA);
    bf16_t* CB = (bf16_t*)(ws + WS_CB); bf16_t* CC = (bf16_t*)(ws + WS_CC); bf16_t* CX = (bf16_t*)(ws + WS_CX); bf16_t* SA = (bf16_t*)(ws + WS_SA); bf16_t* SB = (bf16_t*)(ws + WS_SB);
    bf16_t* MC = (bf16_t*)(ws + WS_MC); bf16_t* M1 = (bf16_t*)(ws + WS_M1); bf16_t* A1 = (bf16_t*)(ws + WS_A1); bf16_t* T = (bf16_t*)(ws + WS_T);

    transpose(w_in, DM, NIN, 0, NIN, WIN, 0, stream);
    transpose(w_ba, 512, DM, 0, DM, WBA, 0, stream);
    transpose(w_bc, DM, DM, 0, DM, WBC, 0, stream);
    transpose(w_out, DM, DM, 0, DM, WOUT, 0, stream);
    transpose(w_mi, DM, FF, 0, FF, WMI, 0, stream);
    transpose(w_mo, FF, DM, 0, DM, WMO, 0, stream);
    hipLaunchKernelGGL(k_mod, dim3(6 * DM / 256), dim3(256), 0, stream, c, w_ada, b_ada, modf);
    hipLaunchKernelGGL(k_derived, dim3(FF / 256), dim3(256), 0, stream, modf, g_mix, g_mlp, w_mi, gs1, gs2, bias2);
    hipLaunchKernelGGL(k_h, dim3(M / 4), dim3(256), 0, stream, x, gs1, modf, H);
    gemm_simple(H, WIN, M, NQKV, DM, EQkv{Q, Kb, Vb}, stream);
    hipLaunchKernelGGL(k_attn_simple, dim3(M * NH / 4), dim3(256), 0, stream, Q, Kb, Vb, lse);
    hipLaunchKernelGGL(k_merge, dim3(M * 64 / 256), dim3(256), 0, stream, Q, lse, OA);
    gemm_simple(H, WIN + (size_t)NQKV * DM, M, NREST, DM, ERest{CB, CC, CX, SA, SB, b_gate}, stream);
    hipLaunchKernelGGL(k_conv, dim3(M * 128 / 256), dim3(256), 0, stream, CB, CC, CX, conv_w);
    gemm_simple(CB, WBC, M, DM, DM, EMc{SB, MC}, stream);
    gemm_simple(OA, WBA, M, DM, 512, EM1{SA, MC, M1}, stream);
    gemm_simple(M1, WOUT, M, DM, DM, EX1{x, modf, gs2, out, A1}, stream);
    hipLaunchKernelGGL(k_rstd, dim3(M / 4), dim3(256), 0, stream, out, r1);
    gemm_simple(A1, WMI, M, FF, DM, ET{r1, bias2, T}, stream);
    gemm_simple(T, WMO, M, DM, FF, EX2{modf, out}, stream);
    hipLaunchKernelGGL(k_final, dim3(M / 4), dim3(256), 0, stream, out, g_fin);
}
```

```cpp
#include <hip/hip_runtime.h>
#include <cstdio>
#include <cstdint>

constexpr int NB = 8, SEQ = 4096, DM = 1024, M = NB * SEQ, NH = 12, HD = 128, AW = NH * HD  , FF = 4096;
constexpr int NIN = 3 * AW + 3 * DM + 2 * DM;
constexpr int NQKV = 3 * AW;
constexpr int NREST = NIN - NQKV;
constexpr int NMOD = 6 * DM;
constexpr float EPS = 1e-6f;
constexpr float LOG2E = 1.4426950408889634f;
constexpr float QSCALE = 0.08838834764831845f * LOG2E;

constexpr size_t MiB = 1u << 20;
constexpr size_t WS_CTL = 0, CTL_ZERO_BYTES = 1 * MiB;
constexpr size_t WS_MODP = 1 * MiB;
constexpr size_t WS_MODF = 3 * MiB;
constexpr size_t WS_BIAS2 = WS_MODF + 384 * 1024;
constexpr size_t WS_SSQ1 = 4 * MiB;
constexpr size_t WS_SSQ2 = 6 * MiB;
constexpr size_t WS_LSE = 8 * MiB;
constexpr size_t WS_WIN = 10 * MiB;
constexpr size_t WS_WBA = 29 * MiB;
constexpr size_t WS_WBC = 30 * MiB;
constexpr size_t WS_WOUT = 32 * MiB;
constexpr size_t WS_WMI = 34 * MiB;
constexpr size_t WS_WMO = 42 * MiB;
constexpr size_t WS_Q = 64 * MiB, WS_K = 160 * MiB, WS_V = 256 * MiB;
constexpr size_t WS_H = 352 * MiB;
constexpr size_t WS_OA = 416 * MiB;
constexpr size_t WS_CB = 160 * MiB, WS_P = 224 * MiB, WS_SA = 448 * MiB, WS_SB = 64 * MiB;
constexpr size_t WS_MC = 288 * MiB;
constexpr size_t WS_M1 = 352 * MiB;
constexpr size_t WS_A1 = 448 * MiB;
constexpr size_t WS_T = 64 * MiB;
constexpr size_t WS_END = 512 * MiB;

namespace pg8 {
#define PG8_LAS __attribute__((address_space(3)))
typedef unsigned short bf16_t;
typedef short bf16x8 __attribute__((ext_vector_type(8)));
typedef float f32x4 __attribute__((ext_vector_type(4)));
typedef unsigned u32x4 __attribute__((ext_vector_type(4)));
constexpr int BM = 256, BK = 64, HALF = 128, HTB = HALF * BK * 2  , STAGE_BYTES = 8 * HTB, NXCD = 8, WGM = 8;

__host__ __device__ __forceinline__ int lds_byte(int r, int c) { const int st = (r >> 4) * 2 + (c >> 5), rr = r & 15, cc = c & 31, ob = rr * 64 + cc * 2; return st * 1024 + (ob ^ (((ob >> 9) & 1) << 5)); }
__host__ __device__ __forceinline__ void stage_rc(int b, int& R, int& C) { const int st = b / 1024, sb = b % 1024, swz = sb ^ (((sb >> 9) & 1) << 5); R = (st >> 1) * 16 + swz / 64; C = (st & 1) * 32 + (swz % 64) / 2; }
__host__ __device__ __forceinline__ int perm32(int rho) { const int n = rho >> 4, i = rho & 15; return 8 * (i >> 2) + 4 * n + (i & 3); }

struct Unit { int pm, pn; };
struct Gemm { const bf16_t* A; const bf16_t* Bt; int M, N, K; };

struct StaticOrder {
    int nM, nN, nwg, G, c;
    __host__ __device__ void init(int M, int N, int G_, int c_) { nM = M / BM; nN = N / BM; nwg = nM * nN; G = G_; c = c_; }
    __host__ __device__ bool next(int i, Unit& u) const {
        const long L = (long)i * G + c; if (L >= nwg) return false;
        int wgid = (int)L; { const int q = nwg / NXCD, r = nwg % NXCD, xcd = wgid % NXCD, off = wgid / NXCD; wgid = (xcd < r ? xcd * (q + 1) : r * (q + 1) + (xcd - r) * q) + off; }
        const int nig = WGM * nN, gid = wgid / nig, fm = gid * WGM, gsz = (nM - fm) < WGM ? (nM - fm) : WGM;
        u.pm = fm + ((wgid % nig) % gsz); u.pn = (wgid % nig) / gsz; return true;
    }
    __device__ __forceinline__ void a_ready(const Unit&) const {}
    __device__ __forceinline__ void done(const Unit&) const {}
};

typedef float f32x2c_t __attribute__((ext_vector_type(2))); typedef __bf16 bf16x2c_t __attribute__((ext_vector_type(2)));
__device__ __forceinline__ unsigned cvt_pk_bf16(float lo, float hi) { f32x2c_t v = {lo, hi}; bf16x2c_t b = __builtin_convertvector(v, bf16x2c_t); return __builtin_bit_cast(unsigned, b); }
typedef float f32x2 __attribute__((ext_vector_type(2)));
template <class Epi, class Sched, bool ALIGN_EPI = false, bool SP2 = false>
__device__ __forceinline__ void gemm_phase(PG8_LAS unsigned char* lds, const Gemm g, const Sched& S, const Epi& E) {
    const int tid = threadIdx.x, wid = __builtin_amdgcn_readfirstlane(tid >> 6), lane = tid & 63, wr = wid >> 2, wc = wid & 3, fr = lane & 15, fq = lane >> 4;
    const int K = g.K, nt = K / BK;
    unsigned voffA[2], voffB[2];
#pragma unroll
    for (int i = 0; i < 2; ++i) { int R, C; stage_rc(tid * 16 + i * 8192, R, C); const int Rb = Epi::PERM ? ((R & ~31) + perm32(R & 31)) : R;
        voffA[i] = (unsigned)(R * K + C) * 2u; voffB[i] = (unsigned)(Rb * K + C) * 2u; }
    const size_t kstep = (size_t)(BK * 2);
    const size_t hstep = (size_t)HALF * K * 2;
    const size_t tstep = 2 * hstep;
    const unsigned ldsw = (unsigned)wid * 1024u;
    const int aoff = lds_byte(wr * 64 + fr, fq * 8), boff = lds_byte(wc * 32 + fr, fq * 8);
#define PG8_SA(b, h) (((b) * 2 + (h)) * HTB)
#define PG8_SB(b, h) ((4 + (b) * 2 + (h)) * HTB)
#define PG8_STAGE(bufoff, gbase, voff) do { _Pragma("unroll") for (int _i = 0; _i < 2; ++_i) \
        __builtin_amdgcn_global_load_lds((const unsigned*)((const char*)(gbase) + (voff)[_i]), (PG8_LAS unsigned*)(lds + (bufoff) + ldsw + _i * 8192), 16, 0, 0); } while (0)
#define PG8_LDA(dst, b, h) do { _Pragma("unroll") for (int m = 0; m < 4; ++m) _Pragma("unroll") for (int k = 0; k < 2; ++k) dst[m][k] = *(const PG8_LAS bf16x8*)(lds + PG8_SA(b, h) + aoff + m * 2048 + k * 1024); } while (0)
#define PG8_LDB(dst, b, h) do { _Pragma("unroll") for (int n = 0; n < 2; ++n) _Pragma("unroll") for (int k = 0; k < 2; ++k) dst[n][k] = *(const PG8_LAS bf16x8*)(lds + PG8_SB(b, h) + boff + n * 2048 + k * 1024); } while (0)
#define PG8_MMA(ai, bj, At, Bt) do { __builtin_amdgcn_s_setprio(1); _Pragma("unroll") for (int m = 0; m < 4; ++m) _Pragma("unroll") for (int n = 0; n < 2; ++n) _Pragma("unroll") for (int k = 0; k < 2; ++k) \
        acc[ai][bj][m][n] = __builtin_amdgcn_mfma_f32_16x16x32_bf16(Bt[n][k], At[m][k], acc[ai][bj][m][n], 0, 0, 0); __builtin_amdgcn_s_setprio(0); } while (0)
#define PG8_WAIT_V(n) asm volatile("s_waitcnt vmcnt(" #n ")" ::: "memory")
#define PG8_WAIT_L(n) asm volatile("s_waitcnt lgkmcnt(" #n ")" ::: "memory")
#define PG8_BAR __builtin_amdgcn_s_barrier()
#define PG8_SCHED __builtin_amdgcn_sched_barrier(0)
    Unit cur, nxt; int ui = 0;
    if (!S.next(0, cur)) return;
    f32x4 acc[2][2][4][2];
#pragma unroll
    for (int a = 0; a < 2; ++a)
#pragma unroll
        for (int b = 0; b < 2; ++b)
#pragma unroll
            for (int m = 0; m < 4; ++m)
#pragma unroll
                for (int n = 0; n < 2; ++n) acc[a][b][m][n] = (f32x4){0.f, 0.f, 0.f, 0.f};
    bf16x8 At[4][2], B0[2][2], B1[2][2];
    const char* cA = (const char*)g.A + (size_t)cur.pm * tstep; const char* cB = (const char*)g.Bt + (size_t)cur.pn * tstep;
    S.a_ready(cur);
    if constexpr (SP2) {
        PG8_STAGE(PG8_SB(0, 0), cB, voffB); PG8_STAGE(PG8_SB(0, 1), cB + hstep, voffB); PG8_STAGE(PG8_SA(0, 0), cA, voffA); PG8_STAGE(PG8_SA(0, 1), cA + hstep, voffA);
        if (wr == 1) PG8_BAR;
        PG8_WAIT_V(2); PG8_BAR;
        PG8_STAGE(PG8_SB(1, 0), cB + kstep, voffB); PG8_STAGE(PG8_SA(1, 0), cA + kstep, voffA); PG8_STAGE(PG8_SB(1, 1), cB + hstep + kstep, voffB);
        PG8_WAIT_V(6); PG8_BAR;
    } else {
        PG8_STAGE(PG8_SB(0, 0), cB, voffB); PG8_STAGE(PG8_SA(0, 0), cA, voffA); PG8_STAGE(PG8_SB(0, 1), cB + hstep, voffB); PG8_STAGE(PG8_SA(0, 1), cA + hstep, voffA);
        if (wr == 1) PG8_BAR;
        PG8_WAIT_V(4); PG8_BAR;
        PG8_STAGE(PG8_SB(1, 0), cB + kstep, voffB); PG8_STAGE(PG8_SA(1, 0), cA + kstep, voffA); PG8_STAGE(PG8_SB(1, 1), cB + hstep + kstep, voffB);
        PG8_WAIT_V(6); PG8_BAR;
    }
    for (;;) {
        const bool has_next = S.next(ui + 1, nxt);
        const char* nA = has_next ? (const char*)g.A + (size_t)nxt.pm * tstep : cA; const char* nB = has_next ? (const char*)g.Bt + (size_t)nxt.pn * tstep : cB;
        for (int t = 0; t < nt; t += 2) {
            const bool last = (t == nt - 2);
            const char* a1 = cA + (size_t)(t + 1) * kstep;
            const char* a2 = last ? nA : cA + (size_t)(t + 2) * kstep; const char* b2 = last ? nB : cB + (size_t)(t + 2) * kstep;
            const char* a3 = a2 + kstep; const char* b3 = b2 + kstep;
            if (last && has_next) S.a_ready(nxt);
            if constexpr (SP2) {
            PG8_LDB(B0, 0, 0); PG8_LDB(B1, 0, 1); PG8_SCHED; PG8_LDA(At, 0, 0); PG8_STAGE(PG8_SA(1, 1), a1 + hstep, voffA);
            PG8_WAIT_V(8); PG8_WAIT_L(0); PG8_BAR; PG8_MMA(0, 0, At, B0); PG8_MMA(0, 1, At, B1); PG8_BAR; PG8_SCHED;
            PG8_LDA(At, 0, 1); PG8_STAGE(PG8_SB(0, 0), b2, voffB); PG8_STAGE(PG8_SB(0, 1), b2 + hstep, voffB); PG8_STAGE(PG8_SA(0, 0), a2, voffA);
            PG8_WAIT_V(8); PG8_WAIT_L(0); PG8_BAR; PG8_MMA(1, 0, At, B0); PG8_MMA(1, 1, At, B1); PG8_BAR; PG8_SCHED;
            PG8_LDB(B0, 1, 0); PG8_LDB(B1, 1, 1); PG8_SCHED; PG8_LDA(At, 1, 0); PG8_STAGE(PG8_SA(0, 1), a2 + hstep, voffA);
            PG8_WAIT_V(8); PG8_WAIT_L(0); PG8_BAR; PG8_MMA(0, 0, At, B0); PG8_MMA(0, 1, At, B1); PG8_BAR; PG8_SCHED;
            PG8_LDA(At, 1, 1); PG8_STAGE(PG8_SB(1, 0), b3, voffB); PG8_STAGE(PG8_SB(1, 1), b3 + hstep, voffB); PG8_STAGE(PG8_SA(1, 0), a3, voffA);
            PG8_WAIT_V(8); PG8_WAIT_L(0); PG8_BAR; PG8_MMA(1, 0, At, B0); PG8_MMA(1, 1, At, B1); PG8_BAR; PG8_SCHED;
            } else {
            PG8_LDB(B0, 0, 0); PG8_SCHED; PG8_LDA(At, 0, 0); PG8_STAGE(PG8_SA(1, 1), a1 + hstep, voffA);
            PG8_WAIT_L(8); PG8_BAR; PG8_WAIT_L(0); PG8_MMA(0, 0, At, B0); PG8_BAR; PG8_SCHED;
            PG8_LDB(B1, 0, 1); PG8_STAGE(PG8_SB(0, 0), b2, voffB);
            PG8_BAR; PG8_WAIT_L(0); PG8_MMA(0, 1, At, B1); PG8_BAR;
            PG8_LDA(At, 0, 1); PG8_STAGE(PG8_SA(0, 0), a2, voffA);
            PG8_BAR; PG8_WAIT_L(0); PG8_MMA(1, 0, At, B0); PG8_BAR; PG8_SCHED;
            PG8_STAGE(PG8_SB(0, 1), b2 + hstep, voffB);
            PG8_WAIT_V(6); PG8_BAR; PG8_MMA(1, 1, At, B1); PG8_BAR;
            PG8_LDB(B0, 1, 0); PG8_SCHED; PG8_LDA(At, 1, 0); PG8_STAGE(PG8_SA(0, 1), a2 + hstep, voffA);
            PG8_WAIT_L(8); PG8_BAR; PG8_WAIT_L(0); PG8_MMA(0, 0, At, B0); PG8_BAR; PG8_SCHED;
            PG8_LDB(B1, 1, 1); PG8_STAGE(PG8_SB(1, 0), b3, voffB);
            PG8_BAR; PG8_WAIT_L(0); PG8_MMA(0, 1, At, B1); PG8_BAR;
            PG8_LDA(At, 1, 1); PG8_STAGE(PG8_SA(1, 0), a3, voffA);
            PG8_BAR; PG8_WAIT_L(0); PG8_MMA(1, 0, At, B0); PG8_BAR; PG8_SCHED;
            PG8_STAGE(PG8_SB(1, 1), b3 + hstep, voffB);
            PG8_WAIT_V(6); PG8_BAR; PG8_MMA(1, 1, At, B1); PG8_BAR;
            }
        }
        if constexpr (ALIGN_EPI) { if (wr == 0) PG8_BAR; }
        if constexpr (!Epi::AFTER_DRAIN) { E(acc, cur, wr, wc, fr, fq); S.done(cur); }
        if (!has_next) break;
#pragma unroll
        for (int a = 0; a < 2; ++a)
#pragma unroll
            for (int b = 0; b < 2; ++b)
#pragma unroll
                for (int m = 0; m < 4; ++m)
#pragma unroll
                    for (int n = 0; n < 2; ++n) acc[a][b][m][n] = (f32x4){0.f, 0.f, 0.f, 0.f};
        cur = nxt; cA = nA; cB = nB; ++ui;
        if constexpr (ALIGN_EPI) { if (wr == 1) PG8_BAR; }
    }
    PG8_WAIT_V(0);
    if constexpr (!ALIGN_EPI) { if (wr == 0) PG8_BAR; }
    PG8_BAR;
    if constexpr (Epi::AFTER_DRAIN) { E.fused(acc, cur, wr, wc, fr, fq, lds, wid, lane); S.done(cur); }
#undef PG8_SA
#undef PG8_SB
#undef PG8_STAGE
#undef PG8_LDA
#undef PG8_LDB
#undef PG8_MMA
#undef PG8_WAIT_V
#undef PG8_WAIT_L
#undef PG8_BAR
#undef PG8_SCHED
}
}
namespace pg8 {
__device__ __forceinline__ u32x4 pack8(const f32x4 v0, const f32x4 v1) { u32x4 w; w.x = cvt_pk_bf16(v0[0], v0[1]); w.y = cvt_pk_bf16(v0[2], v0[3]); w.z = cvt_pk_bf16(v1[0], v1[1]); w.w = cvt_pk_bf16(v1[2], v1[3]); return w; }
__device__ __forceinline__ f32x4 bf_lo4(const u32x4 w) { return (f32x4){__builtin_bit_cast(float, w.x << 16), __builtin_bit_cast(float, w.x & 0xffff0000u), __builtin_bit_cast(float, w.y << 16), __builtin_bit_cast(float, w.y & 0xffff0000u)}; }
__device__ __forceinline__ f32x4 bf_hi4(const u32x4 w) { return (f32x4){__builtin_bit_cast(float, w.z << 16), __builtin_bit_cast(float, w.z & 0xffff0000u), __builtin_bit_cast(float, w.w << 16), __builtin_bit_cast(float, w.w & 0xffff0000u)}; }
__device__ __forceinline__ f32x4 sigmoid4(const f32x4 z) { f32x4 r;
#pragma unroll
    for (int e = 0; e < 4; ++e) r[e] = __builtin_amdgcn_rcpf(1.0f + __builtin_amdgcn_exp2f(-1.4426950408889634f * z[e]));
    return r; }

struct EQkvF {
    static constexpr bool PERM = true, AFTER_DRAIN = false;
    bf16_t* O; int ldc; int split_cols; size_t split_stride; float scale0;
    __device__ __forceinline__ void operator()(const f32x4 (&acc)[2][2][4][2], const Unit& u, int wr, int wc, int fr, int fq) const {
        const int row0 = u.pm * BM + wr * 64 + fr; int colt = u.pn * BM; bf16_t* base = O;
        float sc = 1.f; { const int t = colt / split_cols; base += (size_t)t * split_stride; colt -= t * split_cols; if (t == 0) sc = scale0; }
        const int col0 = colt + wc * 32 + 8 * fq;
#pragma unroll
        for (int ai = 0; ai < 2; ++ai)
#pragma unroll
            for (int m = 0; m < 4; ++m) { bf16_t* rowp = base + (size_t)(row0 + ai * HALF + m * 16) * ldc + col0;
#pragma unroll
                for (int bj = 0; bj < 2; ++bj) *(u32x4*)(rowp + bj * HALF) = pack8(acc[ai][bj][m][0] * sc, acc[ai][bj][m][1] * sc); }
    }
};
struct ERestF {
    static constexpr bool PERM = true, AFTER_DRAIN = false;
    bf16_t *CB, *P, *SA, *SB; const float* b_gate;
    __device__ __forceinline__ void sig_tile(bf16_t* dst, const float* bias, const f32x4 (&acc)[2][2][4][2], int row0, int colt, int wc, int fq) const {
        const int col0 = colt + wc * 32 + 8 * fq; f32x4 bv[2][2];
#pragma unroll
        for (int bj = 0; bj < 2; ++bj)
#pragma unroll
            for (int n = 0; n < 2; ++n) bv[bj][n] = *(const f32x4*)(bias + col0 + bj * HALF + 4 * n);
#pragma unroll
        for (int ai = 0; ai < 2; ++ai)
#pragma unroll
            for (int m = 0; m < 4; ++m) { bf16_t* rowp = dst + (size_t)(row0 + ai * HALF + m * 16) * DM + col0;
#pragma unroll
                for (int bj = 0; bj < 2; ++bj) *(u32x4*)(rowp + bj * HALF) = pack8(sigmoid4(acc[ai][bj][m][0] + bv[bj][0]), sigmoid4(acc[ai][bj][m][1] + bv[bj][1])); }
    }
    __device__ __forceinline__ void operator()(const f32x4 (&acc)[2][2][4][2], const Unit& u, int wr, int wc, int fr, int fq) const {
        const int row0 = u.pm * BM + wr * 64 + fr; const int pn = u.pn;
        if (pn < 4) { const int col0 = pn * BM + wc * 32 + 8 * fq;
#pragma unroll
            for (int ai = 0; ai < 2; ++ai)
#pragma unroll
                for (int m = 0; m < 4; ++m) { bf16_t* rowp = CB + (size_t)(row0 + ai * HALF + m * 16) * DM + col0;
#pragma unroll
                    for (int bj = 0; bj < 2; ++bj) *(u32x4*)(rowp + bj * HALF) = pack8(acc[ai][bj][m][0], acc[ai][bj][m][1]); }
        } else if (pn < 12) { const int col0 = (pn - 4) * HALF + wc * 32 + 8 * fq;
#pragma unroll
            for (int ai = 0; ai < 2; ++ai)
#pragma unroll
                for (int m = 0; m < 4; ++m) *(u32x4*)(P + (size_t)(row0 + ai * HALF + m * 16) * DM + col0) = pack8(acc[ai][0][m][0] * acc[ai][1][m][0], acc[ai][0][m][1] * acc[ai][1][m][1]);
        } else if (pn < 16) sig_tile(SA, b_gate, acc, row0, (pn - 12) * BM, wc, fq);
        else sig_tile(SB, b_gate + DM, acc, row0, (pn - 16) * BM, wc, fq);
    }
};
struct EMcF {
    static constexpr bool PERM = true, AFTER_DRAIN = false;
    const bf16_t* SB; bf16_t* MC;
    __device__ __forceinline__ void operator()(const f32x4 (&acc)[2][2][4][2], const Unit& u, int wr, int wc, int fr, int fq) const {
        const int row0 = u.pm * BM + wr * 64 + fr, col0 = u.pn * BM + wc * 32 + 8 * fq;
#pragma unroll
        for (int ai = 0; ai < 2; ++ai)
#pragma unroll
            for (int m = 0; m < 4; ++m) { const size_t off = (size_t)(row0 + ai * HALF + m * 16) * DM + col0;
#pragma unroll
                for (int bj = 0; bj < 2; ++bj) { const u32x4 s = *(const u32x4*)(SB + off + bj * HALF);
                    *(u32x4*)(MC + off + bj * HALF) = pack8(bf_lo4(s) * acc[ai][bj][m][0], bf_hi4(s) * acc[ai][bj][m][1]); } }
    }
};
struct EM1F {
    static constexpr bool PERM = true, AFTER_DRAIN = false;
    const bf16_t* SA; const bf16_t* MC; bf16_t* M1;
    __device__ __forceinline__ void operator()(const f32x4 (&acc)[2][2][4][2], const Unit& u, int wr, int wc, int fr, int fq) const {
        const int row0 = u.pm * BM + wr * 64 + fr, col0 = u.pn * BM + wc * 32 + 8 * fq;
#pragma unroll
        for (int ai = 0; ai < 2; ++ai)
#pragma unroll
            for (int m = 0; m < 4; ++m) { const size_t off = (size_t)(row0 + ai * HALF + m * 16) * DM + col0;
#pragma unroll
                for (int bj = 0; bj < 2; ++bj) { const u32x4 s = *(const u32x4*)(SA + off + bj * HALF), c = *(const u32x4*)(MC + off + bj * HALF);
                    *(u32x4*)(M1 + off + bj * HALF) = pack8(bf_lo4(s) * acc[ai][bj][m][0] + bf_lo4(c), bf_hi4(s) * acc[ai][bj][m][1] + bf_hi4(c)); } }
    }
};
struct EX1F {
    static constexpr bool PERM = true, AFTER_DRAIN = false;
    const float* x; const float* modf; const float* g_mlp; float* x1; bf16_t* A1; float* ssq;
    __device__ __forceinline__ void operator()(const f32x4 (&acc)[2][2][4][2], const Unit& u, int wr, int wc, int fr, int fq) const {
        const int row0 = u.pm * BM + wr * 64 + fr, col0 = u.pn * BM + wc * 32 + 8 * fq; const int b = (u.pm * BM) / SEQ;
        const float* mb = modf + (size_t)b * NMOD;
        f32x4 gt[2][2], gs[2][2];
#pragma unroll
        for (int bj = 0; bj < 2; ++bj)
#pragma unroll
            for (int n = 0; n < 2; ++n) { const int c = col0 + bj * HALF + 4 * n; gt[bj][n] = *(const f32x4*)(mb + 2 * DM + c);
                gs[bj][n] = *(const f32x4*)(g_mlp + c) * (*(const f32x4*)(mb + 4 * DM + c) + 1.0f); }
#pragma unroll
        for (int ai = 0; ai < 2; ++ai)
#pragma unroll
            for (int m = 0; m < 4; ++m) { const int row = row0 + ai * HALF + m * 16; const size_t off = (size_t)row * DM + col0; float s = 0.f;
#pragma unroll
                for (int bj = 0; bj < 2; ++bj) {
                    const f32x4 v0 = *(const f32x4*)(x + off + bj * HALF) + gt[bj][0] * acc[ai][bj][m][0], v1 = *(const f32x4*)(x + off + bj * HALF + 4) + gt[bj][1] * acc[ai][bj][m][1];
                    *(f32x4*)(x1 + off + bj * HALF) = v0; *(f32x4*)(x1 + off + bj * HALF + 4) = v1;
                    *(u32x4*)(A1 + off + bj * HALF) = pack8(v0 * gs[bj][0], v1 * gs[bj][1]);
                    s += (v0[0] * v0[0] + v0[1] * v0[1]) + (v0[2] * v0[2] + v0[3] * v0[3]) + (v1[0] * v1[0] + v1[1] * v1[1]) + (v1[2] * v1[2] + v1[3] * v1[3]); }
                s += __shfl_xor(s, 16); s += __shfl_xor(s, 32);
                if (fq == 0) ssq[(size_t)row * 16 + 4 * u.pn + wc] = s; }
    }
};
struct ETF {
    static constexpr bool PERM = true, AFTER_DRAIN = false;
    const float* ssq; const float* bias2; bf16_t* T;
    __device__ __forceinline__ void operator()(const f32x4 (&acc)[2][2][4][2], const Unit& u, int wr, int wc, int fr, int fq) const {
        const int row0 = u.pm * BM + wr * 64 + fr, col0 = u.pn * BM + wc * 32 + 8 * fq; const int b = (u.pm * BM) / SEQ;
        f32x4 bv[2][2];
#pragma unroll
        for (int bj = 0; bj < 2; ++bj)
#pragma unroll
            for (int n = 0; n < 2; ++n) bv[bj][n] = *(const f32x4*)(bias2 + (size_t)b * FF + col0 + bj * HALF + 4 * n);
#pragma unroll
        for (int ai = 0; ai < 2; ++ai)
#pragma unroll
            for (int m = 0; m < 4; ++m) { const int row = row0 + ai * HALF + m * 16;
                const f32x4 q = *(const f32x4*)(ssq + (size_t)row * 16 + 4 * fq); float s = (q[0] + q[1]) + (q[2] + q[3]); s += __shfl_xor(s, 16); s += __shfl_xor(s, 32);
                const float r = 1.0f / sqrtf(s * (1.0f / DM) + EPS);
                bf16_t* rowp = T + (size_t)row * FF + col0;
#pragma unroll
                for (int bj = 0; bj < 2; ++bj) { f32x4 v0 = acc[ai][bj][m][0] * r + bv[bj][0], v1 = acc[ai][bj][m][1] * r + bv[bj][1];
#pragma unroll
                    for (int e = 0; e < 4; ++e) { v0[e] = fmaxf(v0[e], 0.f); v1[e] = fmaxf(v1[e], 0.f); }
                    *(u32x4*)(rowp + bj * HALF) = pack8(v0 * v0, v1 * v1); } }
    }
};
struct EX2F {
    static constexpr bool PERM = true, AFTER_DRAIN = false;
    const float* modf; float* x1; float* ssq;
    __device__ __forceinline__ void operator()(const f32x4 (&acc)[2][2][4][2], const Unit& u, int wr, int wc, int fr, int fq) const {
        const int row0 = u.pm * BM + wr * 64 + fr, col0 = u.pn * BM + wc * 32 + 8 * fq; const int b = (u.pm * BM) / SEQ;
        const float* mb = modf + (size_t)b * NMOD + 5 * DM;
        f32x4 gt[2][2];
#pragma unroll
        for (int bj = 0; bj < 2; ++bj)
#pragma unroll
            for (int n = 0; n < 2; ++n) gt[bj][n] = *(const f32x4*)(mb + col0 + bj * HALF + 4 * n);
#pragma unroll
        for (int ai = 0; ai < 2; ++ai)
#pragma unroll
            for (int m = 0; m < 4; ++m) { const int row = row0 + ai * HALF + m * 16; const size_t off = (size_t)row * DM + col0; float s = 0.f;
#pragma unroll
                for (int bj = 0; bj < 2; ++bj) {
                    const f32x4 v0 = *(const f32x4*)(x1 + off + bj * HALF) + gt[bj][0] * acc[ai][bj][m][0], v1 = *(const f32x4*)(x1 + off + bj * HALF + 4) + gt[bj][1] * acc[ai][bj][m][1];
                    *(f32x4*)(x1 + off + bj * HALF) = v0; *(f32x4*)(x1 + off + bj * HALF + 4) = v1;
                    s += (v0[0] * v0[0] + v0[1] * v0[1]) + (v0[2] * v0[2] + v0[3] * v0[3]) + (v1[0] * v1[0] + v1[1] * v1[1]) + (v1[2] * v1[2] + v1[3] * v1[3]); }
                s += __shfl_xor(s, 16); s += __shfl_xor(s, 32);
                if (fq == 0) ssq[(size_t)row * 16 + 4 * u.pn + wc] = s; }
    }
};
}
#define PG8_SP2 true
#define PG8_ALIGN true

#define GAS __attribute__((address_space(1)))
#define LAS __attribute__((address_space(3)))
typedef unsigned short bf16;
typedef unsigned v4u __attribute__((ext_vector_type(4)));
typedef float f32x4 __attribute__((ext_vector_type(4)));
typedef short bf16x8 __attribute__((ext_vector_type(8)));
typedef GAS unsigned gu32;
typedef GAS unsigned long long gu64;
#define RLX_AGENT __ATOMIC_RELAXED, __HIP_MEMORY_SCOPE_AGENT
#define LDS_WAIT() asm volatile("s_waitcnt lgkmcnt(0)" ::: "memory")
#define VM_WAIT() asm volatile("s_waitcnt vmcnt(0)" ::: "memory")
__device__ __forceinline__ unsigned long long rt() { return __builtin_amdgcn_s_memrealtime(); }
__device__ __forceinline__ unsigned f2bf(float f) { unsigned u = __builtin_bit_cast(unsigned, f); return (u + 0x7fffu + ((u >> 16) & 1u)) >> 16; }
__device__ __forceinline__ unsigned pk2(float lo, float hi) { return f2bf(lo) | (f2bf(hi) << 16); }

#define XB_TMO      128
#define XB_XCNT(j)  (256  + 64 * (j))
#define XB_XSUB(j)  (1280 + 64 * (j))
#define XB_XGEN(j)  (2304 + 64 * (j))
#define XB_TOP      3328
#define XB_TOPGEN   3392
#define XCD_BAR_WORDS 3456
#define XB_SPIN_CAP (1u << 18)

__device__ __forceinline__ unsigned xb_ld(unsigned* p)              { return __hip_atomic_load(p, __ATOMIC_RELAXED, __HIP_MEMORY_SCOPE_AGENT); }
__device__ __forceinline__ unsigned xb_add(unsigned* p, unsigned v) { return __hip_atomic_fetch_add(p, v, __ATOMIC_RELAXED, __HIP_MEMORY_SCOPE_AGENT); }
__device__ __forceinline__ unsigned xb_xcc_id() { return (unsigned)__builtin_amdgcn_s_getreg((3 << 11) | 20) & 0xFu; }
#define XB_SPIN(cond, bar) do { unsigned _sp = 0; while (cond) { __builtin_amdgcn_s_sleep(1); \
    if ((++_sp & 255u) == 0u) { if (xb_ld(&(bar)[XB_TMO])) break; if (_sp > XB_SPIN_CAP) { atomicAdd(&(bar)[XB_TMO], 1u); break; } } } } while (0)

struct XcdBarrier {
    unsigned* bar; unsigned x;
    volatile LAS unsigned* st;
};

__device__ __forceinline__ XcdBarrier xcd_barrier_post(unsigned* bar, volatile LAS unsigned* st) {
    XcdBarrier b; b.bar = bar; b.x = xb_xcc_id(); b.st = st;
    if (threadIdx.x == 0) (void)xb_add(&bar[XB_XCNT(b.x)], 1u);
    return b;
}
__device__ __forceinline__ void xcd_barrier_complete(unsigned* bar, unsigned x, unsigned& nloc, unsigned& nx) {
    const unsigned G = gridDim.x * gridDim.y * gridDim.z;
    unsigned sum, cnt, mine, sp = 0u;
    for (;;) {
        sum = 0u; cnt = 0u; mine = 0u;
#pragma unroll
        for (unsigned j = 0; j < 16; ++j) { const unsigned c = xb_ld(&bar[XB_XCNT(j)]); sum += c; cnt += (c > 0u) ? 1u : 0u; mine = (j == x) ? c : mine; }
        if (sum == G) break;
        __builtin_amdgcn_s_sleep(1);
        if ((++sp & 255u) == 0u) { if (xb_ld(&bar[XB_TMO])) break; if (sp > XB_SPIN_CAP) { atomicAdd(&bar[XB_TMO], 1u); break; } }
    }
    nloc = mine > 0u ? mine : 1u; nx = cnt > 0u ? cnt : 1u;
}

__device__ __forceinline__ void xcd_barrier(const XcdBarrier& b) {
    asm volatile("s_waitcnt vmcnt(0)" ::: "memory");
    __syncthreads();
    if (threadIdx.x == 0) {
        unsigned* bar = b.bar;
        __builtin_amdgcn_s_waitcnt(0);
        unsigned nloc = b.st[0], nx = b.st[1];
        if (nloc == 0u) { xcd_barrier_complete(bar, b.x, nloc, nx); b.st[0] = nloc; b.st[1] = nx; }
        const unsigned old = xb_add(&bar[XB_XSUB(b.x)], 1u);
        const unsigned gen = old / nloc;
        if (old + 1u == (gen + 1u) * nloc) {
            __builtin_amdgcn_fence(__ATOMIC_RELEASE, "agent");
            asm volatile("s_waitcnt vmcnt(0)" ::: "memory");
            const unsigned og = xb_add(&bar[XB_TOP], 1u);
            const unsigned tg = og / nx;
            if (og + 1u == (tg + 1u) * nx) xb_add(&bar[XB_TOPGEN], 1u);
            else XB_SPIN(xb_ld(&bar[XB_TOPGEN]) == tg, bar);
            __builtin_amdgcn_fence(__ATOMIC_ACQUIRE, "agent");
            xb_add(&bar[XB_XGEN(b.x)], 1u);
            asm volatile("s_waitcnt vmcnt(0)" ::: "memory");
        } else {
            XB_SPIN(xb_ld(&bar[XB_XGEN(b.x)]) == gen, bar);
            __builtin_amdgcn_fence(__ATOMIC_ACQUIRE, "agent");
            asm volatile("s_waitcnt vmcnt(0)" ::: "memory");
        }
    }
    __syncthreads();
}
constexpr int NWAVES = 8;
constexpr int RING_OFF = 0, RING_BYTES = 131072;
constexpr int LDSCTL_OFF = RING_BYTES, MISC_OFF = LDSCTL_OFF + 320;
constexpr int LDS_BYTES = 147456;
constexpr int CW_TMO = 0, CW_CODE = 1;
constexpr int CW_BAR = 4096;
constexpr int N_PHASES = 12;

struct Frame {
    LAS unsigned char* lds;
    volatile LAS unsigned* MISC;
    gu32* ctl;
    int tid, lane, wave;
    int vcu, G;
};
__device__ __forceinline__ float wave_sum(float v) {
#pragma unroll
    for (int o = 1; o < 64; o <<= 1) v += __shfl_xor(v, o);
    return v;
}
__device__ __forceinline__ float bflo(unsigned w) { return __builtin_bit_cast(float, w << 16); }
__device__ __forceinline__ float bfhi(unsigned w) { return __builtin_bit_cast(float, w & 0xffff0000u); }

__device__ __forceinline__ int remap_win(int n) {
    if (n >= 5632 && n < 6656) { const int j = n - 5632; return 5632 + 256 * (j >> 7) + (j & 127); }
    if (n >= 6656 && n < 7680) { const int j = n - 6656; return 5632 + 256 * (j >> 7) + 128 + (j & 127); }
    return n;
}
__device__ __forceinline__ void p0_transpose_item(const float* W, int K, int N, bf16* WT, bool remap, LAS float* scr, int item, int lane) {
    const int nblk = N / 32, kb = item / nblk, nb = item % nblk, k0 = 64 * kb, n0 = 32 * nb;
    const int r0 = remap ? remap_win(n0) : n0;
#pragma unroll 8
    for (int i = 0; i < 32; ++i) { const int kk = 2 * i + (lane >> 5); scr[kk * 33 + (lane & 31)] = W[(size_t)(k0 + kk) * N + n0 + (lane & 31)]; }
    LDS_WAIT(); asm volatile("" ::: "memory");
    const int c = lane & 7;
#pragma unroll
    for (int j = 0; j < 4; ++j) { const int n = (lane >> 3) + 8 * j; const LAS float* s = scr + (8 * c) * 33 + n;
        v4u o; o.x = pk2(s[0 * 33], s[1 * 33]); o.y = pk2(s[2 * 33], s[3 * 33]); o.z = pk2(s[4 * 33], s[5 * 33]); o.w = pk2(s[6 * 33], s[7 * 33]);
        *(GAS v4u*)(WT + (size_t)(r0 + n) * K + k0 + 8 * c) = o; }
    LDS_WAIT(); asm volatile("" ::: "memory");
}
__device__ __forceinline__ void p0_mod_task(const float* c, const float* w_ada, float* modp, LAS float* scr, int task, int lane) {
    const int kc = task / 96, cg = task % 96, k0 = kc * 128, col = cg * 64 + lane;
#pragma unroll 4
    for (int e = lane; e < 1024; e += 64) { const int kk = e >> 3, b = e & 7; const float cv = c[b * DM + k0 + kk]; scr[kk * 8 + b] = cv / (1.0f + __expf(-cv)); }
    LDS_WAIT(); asm volatile("" ::: "memory");
    float acc[NB];
#pragma unroll
    for (int b = 0; b < NB; ++b) acc[b] = 0.f;
#pragma unroll 4
    for (int kk = 0; kk < 128; ++kk) { const float w = w_ada[(size_t)(k0 + kk) * NMOD + col]; const LAS f32x4* cp = (const LAS f32x4*)(scr + kk * 8); const f32x4 c0 = cp[0], c1 = cp[1];
        acc[0] += c0[0] * w; acc[1] += c0[1] * w; acc[2] += c0[2] * w; acc[3] += c0[3] * w; acc[4] += c1[0] * w; acc[5] += c1[1] * w; acc[6] += c1[2] * w; acc[7] += c1[3] * w; }
#pragma unroll
    for (int b = 0; b < NB; ++b) modp[(size_t)(kc * NB + b) * NMOD + col] = acc[b];
    LDS_WAIT(); asm volatile("" ::: "memory");
}

typedef short v4i16_t __attribute__((ext_vector_type(4)));
struct AttnUnit { int b, h, d, r, n; };
__device__ __forceinline__ AttnUnit attn_decode(int u) {
    AttnUnit a; const int bh = u >> 5, xx = u & 31; a.b = bh / NH; a.h = bh - a.b * NH; const int grp = a.h >> 2; a.d = 1 << (2 * grp);
    const int sh = 5 - 2 * grp; a.r = xx >> sh; a.n = xx & ((1 << sh) - 1); return a;
}
__device__ __forceinline__ void attn_load(const AttnUnit& a, const bf16* QO, const bf16* Kb, const bf16* Vb, int tid, int w, int r15, int g, v4u (&kreg)[8], v4u (&vreg)[8], bf16x8 (&qf)[4]) {
    const int c = tid & 15, kj0 = tid >> 4;
    const size_t hb = (size_t)a.h * HD + c * 8;
#pragma unroll
    for (int it = 0; it < 8; ++it) {
        if (a.n == 0 && it < 4) { kreg[it] = (v4u){0u, 0u, 0u, 0u}; vreg[it] = (v4u){0u, 0u, 0u, 0u}; }
        else { const int kj = kj0 + 32 * it; const long tok = (long)((a.n - 1) * 128 + kj) * a.d + a.r; const size_t off = ((size_t)a.b * SEQ + tok) * AW + hb;
            kreg[it] = *(const GAS v4u*)(Kb + off); vreg[it] = *(const GAS v4u*)(Vb + off); }
    }
    const long tq = (long)(a.n * 128 + 16 * w + r15) * a.d + a.r; const bf16* qp = QO + ((size_t)a.b * SEQ + tq) * AW + a.h * HD + 8 * g;
#pragma unroll
    for (int s = 0; s < 4; ++s) qf[s] = *(const GAS bf16x8*)(qp + 32 * s);
}
__device__ __forceinline__ void attn_phase(Frame& F, bf16* QO, const bf16* Kb, const bf16* Vb, float* lse) {
    const int tid = F.tid, lane = F.lane, w = F.wave, r15 = lane & 15, g = lane >> 4;
    LAS unsigned char* KL = F.lds + RING_OFF; LAS unsigned char* VL = KL + 65536;
    const int t0 = w < 6 ? w : 6;
    int koff[4];
#pragma unroll
    for (int s = 0; s < 4; ++s) koff[s] = t0 * 4096 + r15 * 256 + (((4 * s + g) ^ r15) << 4);
    const int vbase = t0 * 4096 + (4 * g + (r15 >> 2)) * 256 + ((4 * (g & 1) + (r15 >> 2)) << 5) + 8 * (r15 & 3);
    const int sc_ = tid & 15, skj = tid >> 4;
    const int kst = skj * 256 + ((sc_ ^ (skj & 15)) << 4), vst = skj * 256 + (((sc_ >> 1) ^ (skj & 7)) << 5) + ((sc_ & 1) << 4);
    constexpr int NUNITS = NB * NH * 32;
    const int upw = (NUNITS + F.G - 1) / F.G; const int u_lo = F.vcu * upw; const int u_hi = (u_lo + upw) < NUNITS ? (u_lo + upw) : NUNITS;
    if (u_lo >= u_hi) return;
    v4u kreg[8], vreg[8]; bf16x8 qn[4];
    AttnUnit cur = attn_decode(u_lo);
    attn_load(cur, QO, Kb, Vb, tid, w, r15, g, kreg, vreg, qn);
    for (int u = u_lo; u < u_hi; ++u) {
        __syncthreads();
#pragma unroll
        for (int it = 0; it < 8; ++it) { *(LAS v4u*)(KL + kst + it * 8192) = kreg[it]; *(LAS v4u*)(VL + vst + it * 8192) = vreg[it]; }
        bf16x8 qf[4];
#pragma unroll
        for (int s = 0; s < 4; ++s) qf[s] = qn[s];
        __syncthreads();
        const AttnUnit a = cur;
        if (u + 1 < u_hi) { cur = attn_decode(u + 1); attn_load(cur, QO, Kb, Vb, tid, w, r15, g, kreg, vreg, qn); }
        f32x4 sc[10];
#pragma unroll
        for (int ti = 0; ti < 10; ++ti) { f32x4 acc = (f32x4){0.f, 0.f, 0.f, 0.f};
#pragma unroll
            for (int s = 0; s < 4; ++s) { const bf16x8 kf = *(const LAS bf16x8*)(KL + ti * 4096 + koff[s]); acc = __builtin_amdgcn_mfma_f32_16x16x32_bf16(kf, qf[s], acc, 0, 0, 0); }
            sc[ti] = acc; }
        const float slope2 = __builtin_amdgcn_exp2f(-8.0f * (float)(a.h + 1) * (1.0f / 12.0f)) * (float)a.d * LOG2E;
        const int dl0 = 128 + 16 * w + r15 - 16 * t0 - 4 * g;
        const int kj00 = 16 * t0 + 4 * g;
        float mx = -INFINITY;
#pragma unroll
        for (int ti = 0; ti < 10; ++ti)
#pragma unroll
            for (int e = 0; e < 4; ++e) { const int dl = dl0 - 16 * ti - e; const bool ok = ((unsigned)dl <= 128u) && (a.n > 0 || (kj00 + 16 * ti + e) >= 128);
                const float v = ok ? (sc[ti][e] - slope2 * (float)dl) : -INFINITY; sc[ti][e] = v; mx = fmaxf(mx, v); }
        mx = fmaxf(mx, __shfl_xor(mx, 16)); mx = fmaxf(mx, __shfl_xor(mx, 32));
        float l = 0.f;
#pragma unroll
        for (int ti = 0; ti < 10; ++ti)
#pragma unroll
            for (int e = 0; e < 4; ++e) { const float p = __builtin_amdgcn_exp2f(sc[ti][e] - mx); sc[ti][e] = p; l += p; }
        l += __shfl_xor(l, 16); l += __shfl_xor(l, 32);
        bf16x8 pf[5];
#pragma unroll
        for (int kk = 0; kk < 5; ++kk) { const v4u pw = pg8::pack8(sc[2 * kk], sc[2 * kk + 1]); pf[kk] = __builtin_bit_cast(bf16x8, pw); }
        f32x4 o[8];
#pragma unroll
        for (int dt = 0; dt < 8; ++dt) o[dt] = (f32x4){0.f, 0.f, 0.f, 0.f};
#pragma unroll
        for (int kk = 0; kk < 5; ++kk)
#pragma unroll
            for (int dt = 0; dt < 8; ++dt) { const int ad = kk * 8192 + (vbase ^ (dt << 5));
                const v4i16_t lo = __builtin_amdgcn_ds_read_tr16_b64_v4i16((LAS v4i16_t*)(VL + ad)), hi = __builtin_amdgcn_ds_read_tr16_b64_v4i16((LAS v4i16_t*)(VL + ad + 4096));
                const bf16x8 vf = (bf16x8){lo[0], lo[1], lo[2], lo[3], hi[0], hi[1], hi[2], hi[3]};
                o[dt] = __builtin_amdgcn_mfma_f32_16x16x32_bf16(vf, pf[kk], o[dt], 0, 0, 0); }
        const float inv = 1.0f / l;
        const long tq = (long)(a.n * 128 + 16 * w + r15) * a.d + a.r; const size_t mrow = (size_t)a.b * SEQ + tq;
        bf16* op = QO + mrow * AW + a.h * HD + 4 * g;
#pragma unroll
        for (int dt = 0; dt < 8; ++dt) { const f32x4 v = o[dt] * inv; unsigned long long pk = (unsigned long long)pg8::cvt_pk_bf16(v[0], v[1]) | ((unsigned long long)pg8::cvt_pk_bf16(v[2], v[3]) << 32);
            *(GAS unsigned long long*)(op + 16 * dt) = pk; }
        if (g == 0) lse[mrow * NH + a.h] = mx + __builtin_amdgcn_logf(l);
    }
    __syncthreads();
}
struct Args { const float* in[15]; float* out; unsigned char* ws; int ph_lo, ph_hi, li, pad; };

__global__ void __launch_bounds__(NWAVES * 64, 2) fwd_mega(Args args) {
    extern __shared__ __attribute__((aligned(16))) unsigned char lds[];
    Frame F;
    F.lds = (LAS unsigned char*)lds;
    F.MISC = (volatile LAS unsigned*)(F.lds + MISC_OFF);
    F.tid = threadIdx.x; F.lane = F.tid & 63; F.wave = __builtin_amdgcn_readfirstlane(F.tid >> 6);
    F.G = gridDim.x; { const int bx = blockIdx.x; F.vcu = (F.G % 8 == 0) ? (bx % 8) * (F.G / 8) + bx / 8 : bx; }
    unsigned char* ws = args.ws;
    F.ctl = (gu32*)(ws + WS_CTL);
    const float* x = args.in[0]; const float* c_in = args.in[1]; const float* w_ada = args.in[2]; const float* b_ada = args.in[3];
    const float* g_mix = args.in[4]; const float* w_in = args.in[5]; const float* b_gate = args.in[6]; const float* conv_w = args.in[7];
    const float* w_ba = args.in[8]; const float* w_bc = args.in[9]; const float* w_out = args.in[10]; const float* g_mlp = args.in[11];
    const float* w_mi = args.in[12]; const float* w_mo = args.in[13]; const float* g_fin = args.in[14];
    float* out = args.out;
    float* modp = (float*)(ws + WS_MODP); float* modf = (float*)(ws + WS_MODF); float* bias2 = (float*)(ws + WS_BIAS2);
    float* ssq1 = (float*)(ws + WS_SSQ1); float* ssq2 = (float*)(ws + WS_SSQ2); float* lse = (float*)(ws + WS_LSE);
    bf16* WIN = (bf16*)(ws + WS_WIN); bf16* WBA = (bf16*)(ws + WS_WBA); bf16* WBC = (bf16*)(ws + WS_WBC); bf16* WOUT = (bf16*)(ws + WS_WOUT);
    bf16* WMI = (bf16*)(ws + WS_WMI); bf16* WMO = (bf16*)(ws + WS_WMO);
    bf16* Q = (bf16*)(ws + WS_Q); bf16* Kb = (bf16*)(ws + WS_K); bf16* Vb = (bf16*)(ws + WS_V); bf16* H = (bf16*)(ws + WS_H); bf16* OA = (bf16*)(ws + WS_OA);
    bf16* CB = (bf16*)(ws + WS_CB); bf16* P = (bf16*)(ws + WS_P); bf16* SA = (bf16*)(ws + WS_SA); bf16* SB = (bf16*)(ws + WS_SB);
    bf16* MC = (bf16*)(ws + WS_MC); bf16* M1 = (bf16*)(ws + WS_M1); bf16* A1 = (bf16*)(ws + WS_A1); bf16* T = (bf16*)(ws + WS_T);

    for (int u = F.tid; u < (LDS_BYTES - LDSCTL_OFF) / 4; u += NWAVES * 64) ((LAS unsigned*)(F.lds + LDSCTL_OFF))[u] = 0u;
    __syncthreads();
    XcdBarrier bar = xcd_barrier_post((unsigned*)(F.ctl + CW_BAR) + args.li * XCD_BAR_WORDS, F.MISC + 8);
    const int lo = args.ph_lo, hi = args.ph_hi;
#define IN(k) (lo <= (k) && (k) < hi)
#define SEAM(k) do { if (IN(k) && IN((k) + 1)) xcd_barrier(bar); } while (0)
    const int gw = F.vcu * NWAVES + F.wave, NGW = F.G * NWAVES;
    const int gt = F.vcu * (NWAVES * 64) + F.tid, NGT = F.G * NWAVES * 64;

    if (IN(0)) {
        LAS float* scr = (LAS float*)(F.lds + RING_OFF + F.wave * 16384);
        constexpr int I_IN = (DM / 64) * (NIN / 32), I_BA = (512 / 64) * (DM / 32), I_BC = (DM / 64) * (DM / 32), I_OUT = I_BC, I_MI = (DM / 64) * (FF / 32), I_MO = (FF / 64) * (DM / 32), I_MOD = 768;
        constexpr int NITEMS = I_IN + I_BA + I_BC + I_OUT + I_MI + I_MO + I_MOD;
        for (int it = gw; it < NITEMS; it += NGW) {
            int r = it;
            if (r < I_IN) { p0_transpose_item(w_in, DM, NIN, WIN, true, scr, r, F.lane); continue; } r -= I_IN;
            if (r < I_BA) { p0_transpose_item(w_ba, 512, DM, WBA, false, scr, r, F.lane); continue; } r -= I_BA;
            if (r < I_BC) { p0_transpose_item(w_bc, DM, DM, WBC, false, scr, r, F.lane); continue; } r -= I_BC;
            if (r < I_OUT) { p0_transpose_item(w_out, DM, DM, WOUT, false, scr, r, F.lane); continue; } r -= I_OUT;
            if (r < I_MI) { p0_transpose_item(w_mi, DM, FF, WMI, false, scr, r, F.lane); continue; } r -= I_MI;
            if (r < I_MO) { p0_transpose_item(w_mo, FF, DM, WMO, false, scr, r, F.lane); continue; } r -= I_MO;
            p0_mod_task(c_in, w_ada, modp, scr, r, F.lane);
        }
    }
    SEAM(0);
    if (IN(1)) {
        for (int i = gt; i < NB * NMOD; i += NGT) { const int b = i / NMOD, n = i - b * NMOD; float s = b_ada[n];
#pragma unroll
            for (int kc = 0; kc < 8; ++kc) s += modp[(size_t)(kc * NB + b) * NMOD + n];
            modf[i] = s; }
        LAS float* gs = (LAS float*)(F.lds + RING_OFF); LAS float* sh = gs + DM;
        for (int blk = F.vcu; blk < M / 128; blk += F.G) {
            const int b = blk / (SEQ / 128);
            __syncthreads();
            for (int k = F.tid; k < DM; k += NWAVES * 64) { float s1 = b_ada[DM + k], s0 = b_ada[k];
#pragma unroll
                for (int kc = 0; kc < 8; ++kc) { s1 += modp[(size_t)(kc * NB + b) * NMOD + DM + k]; s0 += modp[(size_t)(kc * NB + b) * NMOD + k]; }
                gs[k] = g_mix[k] * (1.0f + s1); sh[k] = s0; }
            __syncthreads();
            for (int j = 0; j < 16; ++j) {
                const int m = blk * 128 + F.wave * 16 + j;
                const GAS f32x4* xr = (const GAS f32x4*)(x + (size_t)m * DM) + F.lane;
                f32x4 v[4]; float s = 0.f;
#pragma unroll
                for (int q = 0; q < 4; ++q) { v[q] = xr[64 * q]; s += (v[q].x * v[q].x + v[q].y * v[q].y) + (v[q].z * v[q].z + v[q].w * v[q].w); }
                const float r = 1.0f / sqrtf(wave_sum(s) * (1.0f / DM) + EPS);
                GAS unsigned long long* o8 = (GAS unsigned long long*)(H + (size_t)m * DM) + F.lane;
#pragma unroll
                for (int q = 0; q < 4; ++q) { const f32x4 g = ((const LAS f32x4*)gs)[F.lane + 64 * q], s4 = ((const LAS f32x4*)sh)[F.lane + 64 * q]; const f32x4 h = v[q] * r * g + s4;
                    o8[64 * q] = (unsigned long long)pk2(h.x, h.y) | ((unsigned long long)pk2(h.z, h.w) << 32); }
            }
        }
        __syncthreads();
    }
    SEAM(1);
    if (IN(2)) {
        for (int nb = F.vcu; nb < FF / 16; nb += F.G) {
#pragma unroll 1
            for (int jn = 0; jn < 2; ++jn) { const int n = nb * 16 + F.wave * 2 + jn;
                const v4u w0 = *(const GAS v4u*)(WMI + (size_t)n * DM + 16 * F.lane), w1 = *(const GAS v4u*)(WMI + (size_t)n * DM + 16 * F.lane + 8);
                float wf[16];
#pragma unroll
                for (int e = 0; e < 4; ++e) { wf[2 * e] = bflo(w0[e]); wf[2 * e + 1] = bfhi(w0[e]); wf[8 + 2 * e] = bflo(w1[e]); wf[8 + 2 * e + 1] = bfhi(w1[e]); }
#pragma unroll 1
                for (int b = 0; b < NB; ++b) { const GAS f32x4* sp = (const GAS f32x4*)(modf + (size_t)b * NMOD + 3 * DM + 16 * F.lane); float s = 0.f;
#pragma unroll
                    for (int q = 0; q < 4; ++q) { const f32x4 t = sp[q]; s += t[0] * wf[4 * q] + t[1] * wf[4 * q + 1] + t[2] * wf[4 * q + 2] + t[3] * wf[4 * q + 3]; }
                    s = wave_sum(s); if (F.lane == 0) bias2[(size_t)b * FF + n] = s; } }
        }
        pg8::Gemm g{H, WIN, M, NQKV, DM}; pg8::StaticOrder S; S.init(M, NQKV, F.G, (int)blockIdx.x);
        pg8::EQkvF E{Q, AW, AW, (size_t)(WS_K - WS_Q) / 2, QSCALE};
        pg8::gemm_phase<pg8::EQkvF, pg8::StaticOrder, PG8_ALIGN, PG8_SP2>(F.lds + RING_OFF, g, S, E);
    }
    SEAM(2);
    if (IN(3)) { attn_phase(F, Q, Kb, Vb, lse); }
    SEAM(3);
    if (IN(4)) {
        for (long idx = gt; idx < (long)M * 64; idx += NGT) {
            const int ch = (int)(idx & 15), slot = (int)((idx >> 4) & 3); const int m = (int)(idx >> 6);
            const float l0 = lse[(size_t)m * NH + slot], l1 = lse[(size_t)m * NH + 4 + slot], l2 = lse[(size_t)m * NH + 8 + slot];
            const float mx = fmaxf(fmaxf(l0, l1), l2); float w0 = __builtin_amdgcn_exp2f(l0 - mx), w1 = __builtin_amdgcn_exp2f(l1 - mx), w2 = __builtin_amdgcn_exp2f(l2 - mx);
            const float inv = 1.0f / (w0 + w1 + w2); w0 *= inv; w1 *= inv; w2 *= inv;
            const v4u a = *(const GAS v4u*)(Q + (size_t)m * AW + (0 + slot) * HD + ch * 8), bq = *(const GAS v4u*)(Q + (size_t)m * AW + (4 + slot) * HD + ch * 8), cq = *(const GAS v4u*)(Q + (size_t)m * AW + (8 + slot) * HD + ch * 8);
            v4u o;
#pragma unroll
            for (int e = 0; e < 4; ++e) o[e] = pk2(w0 * bflo(a[e]) + w1 * bflo(bq[e]) + w2 * bflo(cq[e]), w0 * bfhi(a[e]) + w1 * bfhi(bq[e]) + w2 * bfhi(cq[e]));
            *(GAS v4u*)(OA + (size_t)m * 512 + slot * HD + ch * 8) = o;
        }
    }
    SEAM(4);
    if (IN(5)) {
        pg8::Gemm g{H, WIN + (size_t)NQKV * DM, M, NREST, DM}; pg8::StaticOrder S; S.init(M, NREST, F.G, (int)blockIdx.x);
        pg8::ERestF E{CB, P, SA, SB, b_gate};
        pg8::gemm_phase<pg8::ERestF, pg8::StaticOrder, PG8_ALIGN, PG8_SP2>(F.lds + RING_OFF, g, S, E);
    }
    SEAM(5);
    if (IN(6)) {
        for (long idx = gt; idx < (long)M * 128; idx += NGT) {
            const int ch = (int)(idx & 127); const int m = (int)(idx >> 7); const int t = m % SEQ;
            float uu[8];
#pragma unroll
            for (int e = 0; e < 8; ++e) uu[e] = 0.f;
#pragma unroll
            for (int tap = 0; tap < 3; ++tap) { const int back = 2 - tap;
                if (t - back >= 0) { const v4u a = *(const GAS v4u*)(P + (size_t)(m - back) * DM + ch * 8);
                    const f32x4 w0 = *(const GAS f32x4*)(conv_w + tap * DM + ch * 8), w1 = *(const GAS f32x4*)(conv_w + tap * DM + ch * 8 + 4);
                    uu[0] += w0[0] * bflo(a[0]); uu[1] += w0[1] * bfhi(a[0]); uu[2] += w0[2] * bflo(a[1]); uu[3] += w0[3] * bfhi(a[1]);
                    uu[4] += w1[0] * bflo(a[2]); uu[5] += w1[1] * bfhi(a[2]); uu[6] += w1[2] * bflo(a[3]); uu[7] += w1[3] * bfhi(a[3]); } }
            const v4u cbv = *(const GAS v4u*)(CB + (size_t)m * DM + ch * 8); v4u o;
#pragma unroll
            for (int e = 0; e < 4; ++e) o[e] = pk2(bflo(cbv[e]) * uu[2 * e], bfhi(cbv[e]) * uu[2 * e + 1]);
            *(GAS v4u*)(CB + (size_t)m * DM + ch * 8) = o;
        }
    }
    SEAM(6);
    if (IN(7)) {
        { pg8::Gemm g{CB, WBC, M, DM, DM}; pg8::StaticOrder S; S.init(M, DM, F.G, (int)blockIdx.x); pg8::EMcF E{SB, MC};
          pg8::gemm_phase<pg8::EMcF, pg8::StaticOrder, PG8_ALIGN, PG8_SP2>(F.lds + RING_OFF, g, S, E); }
        { pg8::Gemm g{OA, WBA, M, DM, 512}; pg8::StaticOrder S; S.init(M, DM, F.G, (int)blockIdx.x); pg8::EM1F E{SA, MC, M1};
          pg8::gemm_phase<pg8::EM1F, pg8::StaticOrder, PG8_ALIGN, PG8_SP2>(F.lds + RING_OFF, g, S, E); }
    }
    SEAM(7);
    if (IN(8)) {
        pg8::Gemm g{M1, WOUT, M, DM, DM}; pg8::StaticOrder S; S.init(M, DM, F.G, (int)blockIdx.x); pg8::EX1F E{x, modf, g_mlp, out, A1, ssq1};
        pg8::gemm_phase<pg8::EX1F, pg8::StaticOrder, PG8_ALIGN, PG8_SP2>(F.lds + RING_OFF, g, S, E);
    }
    SEAM(8);
    if (IN(9)) {
        pg8::Gemm g{A1, WMI, M, FF, DM}; pg8::StaticOrder S; S.init(M, FF, F.G, (int)blockIdx.x); pg8::ETF E{ssq1, bias2, T};
        pg8::gemm_phase<pg8::ETF, pg8::StaticOrder, PG8_ALIGN, PG8_SP2>(F.lds + RING_OFF, g, S, E);
    }
    SEAM(9);
    if (IN(10)) {
        pg8::Gemm g{T, WMO, M, DM, FF}; pg8::StaticOrder S; S.init(M, DM, F.G, (int)blockIdx.x); pg8::EX2F E{modf, out, ssq2};
        pg8::gemm_phase<pg8::EX2F, pg8::StaticOrder, PG8_ALIGN, PG8_SP2>(F.lds + RING_OFF, g, S, E);
    }
    SEAM(10);
    if (IN(11)) {
        const unsigned bad = __hip_atomic_load((gu32*)((unsigned*)(F.ctl + CW_BAR) + args.li * XCD_BAR_WORDS + XB_TMO), RLX_AGENT);
        for (int m = gw; m < M; m += NGW) {
            float s = (F.lane < 16) ? ssq2[(size_t)m * 16 + F.lane] : 0.f; s = wave_sum(s);
            float r = 1.0f / sqrtf(s * (1.0f / DM) + EPS); if (bad) r = __builtin_nanf("");
            GAS f32x4* xr = (GAS f32x4*)(out + (size_t)m * DM) + F.lane;
#pragma unroll
            for (int q = 0; q < 4; ++q) xr[64 * q] = xr[64 * q] * r * ((const GAS f32x4*)g_fin)[F.lane + 64 * q];
        }
    }
#undef IN
#undef SEAM
}
#ifndef MK_MODE
#define MK_MODE 0
#endif
#if MK_MODE >= 2
__global__ void __launch_bounds__(256) k_attn_simple(bf16* QO, const bf16* __restrict__ Kb, const bf16* __restrict__ Vb, float* __restrict__ LSE) {
    __shared__ __attribute__((aligned(16))) bf16 qs[4][HD];
    __shared__ float ps[4][192];
    const int wave = threadIdx.x >> 6, lane = threadIdx.x & 63;
    const long wid = (long)blockIdx.x * 4 + wave;
    const int m = (int)(wid / NH), h = (int)(wid % NH);
    const int b = m / SEQ, t = m % SEQ;
    const int grp = h >> 2, d = grp == 0 ? 1 : (grp == 1 ? 4 : 16);
    const int r = t % d, j = t / d;
    const float slope2 = exp2f(-8.0f * (float)(h + 1) / 12.0f) * (float)d * LOG2E;
    ((unsigned*)qs[wave])[lane] = ((const unsigned*)(QO + (size_t)m * AW + h * HD))[lane];
    __syncthreads();
    float sc[3];
#pragma unroll
    for (int rr = 0; rr < 3; ++rr) {
        const int dl = rr * 64 + lane; const bool valid = dl <= 128 && j - dl >= 0;
        float s = -INFINITY;
        if (valid) {
            const bf16* kr = Kb + ((size_t)b * SEQ + (size_t)(j - dl) * d + r) * AW + h * HD;
            float acc = 0.f;
#pragma unroll
            for (int ch = 0; ch < 16; ++ch) {
                const v4u kv = *(const v4u*)(kr + ch * 8); const v4u qv = *(const v4u*)(qs[wave] + ch * 8);
#pragma unroll
                for (int e = 0; e < 4; ++e) { acc += bflo(kv[e]) * bflo(qv[e]); acc += bfhi(kv[e]) * bfhi(qv[e]); }
            }
            s = acc - slope2 * (float)dl;
        }
        sc[rr] = s;
    }
    float mx = fmaxf(fmaxf(sc[0], sc[1]), sc[2]);
#pragma unroll
    for (int o = 1; o < 64; o <<= 1) mx = fmaxf(mx, __shfl_xor(mx, o));
    float lsum = 0.f;
#pragma unroll
    for (int rr = 0; rr < 3; ++rr) { const float p = exp2f(sc[rr] - mx); lsum += p; ps[wave][rr * 64 + lane] = p; }
    lsum = wave_sum(lsum);
    __syncthreads();
    float o0 = 0.f, o1 = 0.f;
    const int nk = j < 128 ? j : 128;
    for (int dl = 0; dl <= nk; ++dl) {
        const float p = ps[wave][dl];
        const unsigned vv = ((const unsigned*)(Vb + ((size_t)b * SEQ + (size_t)(j - dl) * d + r) * AW + h * HD))[lane];
        o0 += p * bflo(vv); o1 += p * bfhi(vv);
    }
    const float inv = 1.f / lsum;
    ((unsigned*)(QO + (size_t)m * AW + h * HD))[lane] = pk2(o0 * inv, o1 * inv);
    if (lane == 0) LSE[(size_t)m * NH + h] = mx + log2f(lsum);
}
#endif


#ifndef MK_SIMPLE
#define MK_SIMPLE 0
#endif
template <class Epi>
__global__ void __launch_bounds__(256) k_gemm_simple(const bf16* __restrict__ A, const bf16* __restrict__ Bt, int Mm, int N, int K, Epi e) {
    const int wave = threadIdx.x >> 6, lane = threadIdx.x & 63, r = lane & 15, g = lane >> 4;
    const int tiles_n = N / 64; const long tile = (long)blockIdx.x * 4 + wave; const int tm = (int)(tile / tiles_n), tn = (int)(tile % tiles_n);
    if (tm * 64 >= Mm) return;
    f32x4 acc[4][4];
#pragma unroll
    for (int i = 0; i < 4; ++i)
#pragma unroll
        for (int j = 0; j < 4; ++j) acc[i][j] = (f32x4){0.f, 0.f, 0.f, 0.f};
    const bf16* Ap = A + (size_t)(tm * 64 + r) * K + 8 * g; const bf16* Bp = Bt + (size_t)(tn * 64 + r) * K + 8 * g;
    for (int k0 = 0; k0 < K; k0 += 32) { bf16x8 a[4], b[4];
#pragma unroll
        for (int i = 0; i < 4; ++i) { a[i] = *(const bf16x8*)(Ap + (size_t)i * 16 * K + k0); b[i] = *(const bf16x8*)(Bp + (size_t)i * 16 * K + k0); }
#pragma unroll
        for (int i = 0; i < 4; ++i)
#pragma unroll
            for (int j = 0; j < 4; ++j) acc[i][j] = __builtin_amdgcn_mfma_f32_16x16x32_bf16(a[i], b[j], acc[i][j], 0, 0, 0); }
#pragma unroll
    for (int i = 0; i < 4; ++i)
#pragma unroll
        for (int j = 0; j < 4; ++j)
#pragma unroll
            for (int q = 0; q < 4; ++q) e(tm * 64 + i * 16 + 4 * g + q, tn * 64 + j * 16 + r, acc[i][j][q]);
}
struct SQkv { bf16 *Q, *K, *V;
    __device__ __forceinline__ void operator()(int row, int col, float a) const { const int t = col / AW, c = col - t * AW; const size_t i = (size_t)row * AW + c;
        if (t == 0) Q[i] = (bf16)f2bf(a * QSCALE); else if (t == 1) K[i] = (bf16)f2bf(a); else V[i] = (bf16)f2bf(a); } };
struct SRest { bf16 *CB, *SA, *SB; bf16* TMP; const float* b_gate;
    __device__ __forceinline__ void operator()(int row, int col, float a) const {
        if (col < 1024) CB[(size_t)row * DM + col] = (bf16)f2bf(a);
        else if (col < 3072) TMP[(size_t)row * 2048 + (col - 1024)] = (bf16)f2bf(a);
        else { const int t = (col - 3072) >> 10, c = (col - 3072) & 1023; const float z = a + b_gate[t * DM + c]; const float sg = 1.f / (1.f + __expf(-z));
            if (t == 0) SA[(size_t)row * DM + c] = (bf16)f2bf(sg); else SB[(size_t)row * DM + c] = (bf16)f2bf(sg); } } };
__global__ void k_pairmul(const bf16* __restrict__ TMP, bf16* __restrict__ P) {
    const long idx = (long)blockIdx.x * blockDim.x + threadIdx.x; const int c = (int)(idx & 1023); const int m = (int)(idx >> 10);
    const int p = c >> 7, j = c & 127; P[(size_t)m * DM + c] = (bf16)f2bf(bflo(TMP[(size_t)m * 2048 + 256 * p + j]) * bflo(TMP[(size_t)m * 2048 + 256 * p + 128 + j])); }
struct SMc { const bf16* SB; bf16* MC;
    __device__ __forceinline__ void operator()(int row, int col, float a) const { const size_t i = (size_t)row * DM + col; MC[i] = (bf16)f2bf(bflo(SB[i]) * a); } };
struct SM1 { const bf16* SA; const bf16* MC; bf16* M1;
    __device__ __forceinline__ void operator()(int row, int col, float a) const { const size_t i = (size_t)row * DM + col; M1[i] = (bf16)f2bf(bflo(SA[i]) * a + bflo(MC[i])); } };
struct SX1 { const float* x; const float* modf; const float* g_mlp; float* x1; bf16* A1;
    __device__ __forceinline__ void operator()(int row, int col, float a) const { const size_t i = (size_t)row * DM + col; const int b = row / SEQ;
        const float v = x[i] + modf[b * NMOD + 2 * DM + col] * a; x1[i] = v; A1[i] = (bf16)f2bf(v * g_mlp[col] * (1.f + modf[b * NMOD + 4 * DM + col])); } };
__global__ void k_ssq(const float* __restrict__ x1, float* __restrict__ ssq) {
    const int lane = threadIdx.x & 63; const int m = blockIdx.x * 4 + (threadIdx.x >> 6);
    const f32x4* xr = (const f32x4*)(x1 + (size_t)m * DM) + lane; float s[4];
#pragma unroll
    for (int j = 0; j < 4; ++j) { const f32x4 v = xr[64 * j]; s[j] = (v.x * v.x + v.y * v.y) + (v.z * v.z + v.w * v.w); }
#pragma unroll
    for (int j = 0; j < 4; ++j) { float t = s[j]; t += __shfl_xor(t, 1); t += __shfl_xor(t, 2); t += __shfl_xor(t, 4); t += __shfl_xor(t, 8); if ((lane & 15) == 0) ssq[(size_t)m * 16 + 4 * j + (lane >> 4)] = t; }
}
struct ST { const float* ssq; const float* bias2; bf16* T;
    __device__ __forceinline__ void operator()(int row, int col, float a) const { const int b = row / SEQ; float s = 0.f;
        for (int i = 0; i < 16; ++i) s += ssq[(size_t)row * 16 + i];
        float v = (1.0f / sqrtf(s * (1.0f / DM) + EPS)) * a + bias2[b * FF + col]; v = fmaxf(v, 0.f); T[(size_t)row * FF + col] = (bf16)f2bf(v * v); } };
struct SX2 { const float* modf; float* x1;
    __device__ __forceinline__ void operator()(int row, int col, float a) const { const size_t i = (size_t)row * DM + col; const int b = row / SEQ; x1[i] = x1[i] + modf[b * NMOD + 5 * DM + col] * a; } };
__global__ void k_bias2_simple(const float* __restrict__ modf, const float* __restrict__ w_mi, float* __restrict__ bias2) {
    const int n = blockIdx.x * blockDim.x + threadIdx.x; float acc[NB];
#pragma unroll
    for (int b = 0; b < NB; ++b) acc[b] = 0.f;
    for (int k = 0; k < DM; ++k) { const float w = w_mi[(size_t)k * FF + n];
#pragma unroll
        for (int b = 0; b < NB; ++b) acc[b] += modf[b * NMOD + 3 * DM + k] * w; }
#pragma unroll
    for (int b = 0; b < NB; ++b) bias2[b * FF + n] = acc[b];
}
template <class Epi> static void gemm_simple(const bf16* A, const bf16* Bt, int Mm, int N, int K, Epi e, hipStream_t s) {
    const long tiles = (long)(Mm / 64) * (N / 64); hipLaunchKernelGGL(k_gemm_simple<Epi>, dim3((unsigned)(tiles / 4)), dim3(256), 0, s, A, Bt, Mm, N, K, e); }

extern "C" void kernel_launch(void* const* d_in, const int* in_sizes, int n_in, void* d_out, int out_size, void* d_ws, size_t ws_size, hipStream_t stream) {
    static int grid = 0;
    if (grid == 0) {
        if (n_in != 15 || in_sizes[0] != M * DM || out_size != M * DM || ws_size < WS_END) { fprintf(stderr, "kernel_launch: unexpected shapes (n_in %d in0 %d out %d ws %zu); nothing launched\n", n_in, n_in > 0 ? in_sizes[0] : -1, out_size, ws_size); grid = -1; return; }
        int dev = 0, cus = 0, per_cu = 0;
        if (hipGetDevice(&dev) != hipSuccess || hipDeviceGetAttribute(&cus, hipDeviceAttributeMultiprocessorCount, dev) != hipSuccess) { fprintf(stderr, "kernel_launch: device query failed\n"); grid = -1; return; }
        if (hipFuncSetAttribute((const void*)fwd_mega, hipFuncAttributeMaxDynamicSharedMemorySize, LDS_BYTES) != hipSuccess) { fprintf(stderr, "kernel_launch: hipFuncSetAttribute failed\n"); grid = -1; return; }
        if (hipOccupancyMaxActiveBlocksPerMultiprocessor(&per_cu, (const void*)fwd_mega, NWAVES * 64, LDS_BYTES) != hipSuccess || per_cu < 1) { fprintf(stderr, "kernel_launch: occupancy query reports %d blocks per CU\n", per_cu); }
        (void)hipGetLastError();
        grid = cus;
    }
    if (grid < 0) return;
    if (hipMemsetAsync((char*)d_ws + WS_CTL, 0, CTL_ZERO_BYTES, stream) != hipSuccess) { fprintf(stderr, "kernel_launch: memset failed\n"); return; }
    Args a{};
    for (int i = 0; i < 15; ++i) a.in[i] = (const float*)d_in[i];
    a.out = (float*)d_out; a.ws = (unsigned char*)d_ws;
#if MK_MODE == 0
    a.ph_lo = 0; a.ph_hi = N_PHASES; a.li = 0;
    { void* kargs[] = {&a}; const hipError_t e = hipLaunchCooperativeKernel((const void*)fwd_mega, dim3(grid), dim3(NWAVES * 64), kargs, LDS_BYTES, stream);
      if (e != hipSuccess) fprintf(stderr, "kernel_launch: cooperative launch failed: %s (grid %d)\n", hipGetErrorString(e), grid); }
#elif MK_MODE == 1
    for (int p = 0; p < N_PHASES; ++p) { a.ph_lo = p; a.ph_hi = p + 1; a.li = 0; hipLaunchKernelGGL(fwd_mega, dim3(grid), dim3(NWAVES * 64), LDS_BYTES, stream, a); }
#elif MK_MODE == 3
    for (int p = 0; p < N_PHASES; ++p) {
        if (p == 3) { hipLaunchKernelGGL(k_attn_simple, dim3(M * NH / 4), dim3(256), 0, stream, (bf16*)((char*)d_ws + WS_Q), (const bf16*)((char*)d_ws + WS_K), (const bf16*)((char*)d_ws + WS_V), (float*)((char*)d_ws + WS_LSE)); continue; }
        if ((MK_SIMPLE >> p) & 1) {
            unsigned char* ws = (unsigned char*)d_ws; float* out = (float*)d_out; const float* x = (const float*)d_in[0];
            float* modf = (float*)(ws + WS_MODF); float* bias2 = (float*)(ws + WS_BIAS2); float* ssq1 = (float*)(ws + WS_SSQ1); float* ssq2 = (float*)(ws + WS_SSQ2);
            bf16* WIN = (bf16*)(ws + WS_WIN); bf16* WBA = (bf16*)(ws + WS_WBA); bf16* WBC = (bf16*)(ws + WS_WBC); bf16* WOUT = (bf16*)(ws + WS_WOUT); bf16* WMI = (bf16*)(ws + WS_WMI); bf16* WMO = (bf16*)(ws + WS_WMO);
            bf16* Q = (bf16*)(ws + WS_Q); bf16* Kb = (bf16*)(ws + WS_K); bf16* Vb = (bf16*)(ws + WS_V); bf16* H = (bf16*)(ws + WS_H); bf16* OA = (bf16*)(ws + WS_OA);
            bf16* CB = (bf16*)(ws + WS_CB); bf16* P = (bf16*)(ws + WS_P); bf16* SA = (bf16*)(ws + WS_SA); bf16* SB = (bf16*)(ws + WS_SB); bf16* MC = (bf16*)(ws + WS_MC); bf16* M1 = (bf16*)(ws + WS_M1); bf16* A1 = (bf16*)(ws + WS_A1); bf16* T = (bf16*)(ws + WS_T);
            if (p == 2) { hipLaunchKernelGGL(k_bias2_simple, dim3(FF / 256), dim3(256), 0, stream, modf, (const float*)d_in[12], bias2); gemm_simple(H, WIN, M, NQKV, DM, SQkv{Q, Kb, Vb}, stream); continue; }
            if (p == 5) { gemm_simple(H, WIN + (size_t)NQKV * DM, M, NREST, DM, SRest{CB, SA, SB, (bf16*)d_out, (const float*)d_in[6]}, stream); hipLaunchKernelGGL(k_pairmul, dim3(M * 1024 / 256), dim3(256), 0, stream, (const bf16*)d_out, P); continue; }
            if (p == 7) { gemm_simple(CB, WBC, M, DM, DM, SMc{SB, MC}, stream); gemm_simple(OA, WBA, M, DM, 512, SM1{SA, MC, M1}, stream); continue; }
            if (p == 8) { gemm_simple(M1, WOUT, M, DM, DM, SX1{x, modf, (const float*)d_in[11], out, A1}, stream); hipLaunchKernelGGL(k_ssq, dim3(M / 4), dim3(256), 0, stream, out, ssq1); continue; }
            if (p == 9) { gemm_simple(A1, WMI, M, FF, DM, ST{ssq1, bias2, T}, stream); continue; }
            if (p == 10) { gemm_simple(T, WMO, M, DM, FF, SX2{modf, out}, stream); hipLaunchKernelGGL(k_ssq, dim3(M / 4), dim3(256), 0, stream, out, ssq2); continue; }
        }
        a.ph_lo = p; a.ph_hi = p + 1; a.li = 0; hipLaunchKernelGGL(fwd_mega, dim3(grid), dim3(NWAVES * 64), LDS_BYTES, stream, a); }
#else
    a.ph_lo = 0; a.ph_hi = 3; a.li = 0; hipLaunchKernelGGL(fwd_mega, dim3(grid), dim3(NWAVES * 64), LDS_BYTES, stream, a);
    hipLaunchKernelGGL(k_attn_simple, dim3(M * NH / 4), dim3(256), 0, stream, (bf16*)((char*)d_ws + WS_Q), (const bf16*)((char*)d_ws + WS_K), (const bf16*)((char*)d_ws + WS_V), (float*)((char*)d_ws + WS_LSE));
    a.ph_lo = 4; a.ph_hi = N_PHASES; a.li = 1; hipLaunchKernelGGL(fwd_mega, dim3(grid), dim3(NWAVES * 64), LDS_BYTES, stream, a);
#endif
}
```
